# Optimizing an MI355X kernel written in HIP

```python
import math
import jax, jax.numpy as jnp
from jax import lax
import numpy as np

D_MODEL = 1024
BATCH = 8
SEQ = 2048
DEPTH = 1
DEC_BATCH = 16
DEC_SEQ = 4096
PAST_LEN = 128

N_DN = 4
DK_DN = 128
DV_DN = 128
DN_CONV = 5
CHUNK = 64
N_DA = 4
DH_DA = 64
Q_BLOCK = 128
ROT_DIM = DH_DA // 4
ROPE_THETA = 500000.0
D_FF = 2816
FFN_CONV = 3
PLE_DIM = 256
EPS = 1e-6

DN_QK = N_DN * DK_DN
DN_V = N_DN * DV_DN
DA_QK = N_DA * 2 * DH_DA
DA_V = N_DA * 2 * DH_DA
MIX_WIDTH = DN_V + DA_V
SPLIT_SIZES = [DN_QK, DN_QK, DN_V, DN_V, 2 * N_DN, 2 * N_DN, DA_QK, DA_QK, DA_V]
IN_COLS = int(sum(SPLIT_SIZES))
SPLIT_IDX = [int(c) for c in np.cumsum(SPLIT_SIZES)[:-1]]

kernel_name = "hybrid_bidir_deltanet_diffattn_encoder"


def rms_norm(x, g):
    xf = x.astype(jnp.float32)
    y = xf * lax.rsqrt(jnp.mean(xf * xf, axis=-1, keepdims=True) + EPS)
    return (y * g.astype(jnp.float32)).astype(x.dtype)


def l2_norm(x):
    return x * lax.rsqrt(jnp.sum(x * x, axis=-1, keepdims=True) + EPS)


def centred_dwconv(x, w):
    k = w.shape[0]
    r = k // 2
    s = x.shape[1]
    xp = jnp.pad(x, ((0, 0), (r, r), (0, 0)))
    out = xp[:, 0:s] * w[0]
    for j in range(1, k):
        out = out + xp[:, j:j + s] * w[j]
    return out


def rope_tables(s):
    inv_freq = ROPE_THETA ** (-jnp.arange(0, ROT_DIM, 2, dtype=jnp.float32) / ROT_DIM)
    ang = jnp.arange(s, dtype=jnp.float32)[:, None] * inv_freq[None, :]
    return jnp.cos(ang), jnp.sin(ang)


def partial_rope(x, cos, sin):
    c = cos[None, :, None, None, :].astype(x.dtype)
    s_ = sin[None, :, None, None, :].astype(x.dtype)
    half = ROT_DIM // 2
    x1 = x[..., :half]
    x2 = x[..., half:ROT_DIM]
    return jnp.concatenate([x1 * c - x2 * s_, x2 * c + x1 * s_, x[..., ROT_DIM:]], axis=-1)


def gated_delta_rule(q, k, v, g, beta):
    out_dtype = v.dtype
    b, t, h, dk = q.shape
    dv = v.shape[-1]
    n = t // CHUNK
    f32 = jnp.float32
    q = q.astype(f32).transpose(0, 2, 1, 3).reshape(b, h, n, CHUNK, dk)
    k = k.astype(f32).transpose(0, 2, 1, 3).reshape(b, h, n, CHUNK, dk)
    v = v.astype(f32).transpose(0, 2, 1, 3).reshape(b, h, n, CHUNK, dv)
    g = g.astype(f32).transpose(0, 2, 1).reshape(b, h, n, CHUNK)
    beta = beta.astype(f32).transpose(0, 2, 1).reshape(b, h, n, CHUNK)

    gc = jnp.cumsum(g, axis=-1)
    tril = jnp.tril(jnp.ones((CHUNK, CHUNK), dtype=bool))
    strict = jnp.tril(jnp.ones((CHUNK, CHUNK), dtype=bool), -1)
    decay = jnp.exp(jnp.where(tril, gc[..., :, None] - gc[..., None, :], -jnp.inf))

    kb = k * beta[..., None]
    lower = jnp.where(strict, jnp.einsum('bhnid,bhnjd->bhnij', kb, k) * decay, 0.0)
    rhs = jnp.concatenate([v * beta[..., None], kb * jnp.exp(gc)[..., None]], axis=-1)
    sol = lax.linalg.triangular_solve(lower, rhs, left_side=True, lower=True, unit_diagonal=True)
    u = sol[..., :dv]
    w = sol[..., dv:]

    qk = jnp.einsum('bhnid,bhnjd->bhnij', q, k) * decay
    q_dec = q * jnp.exp(gc)[..., None]
    k_dec = k * jnp.exp(gc[..., -1:] - gc)[..., None]
    g_last = jnp.exp(gc[..., -1])

    xs = tuple(jnp.moveaxis(a, 2, 0) for a in (qk, q_dec, k_dec, u, w, g_last))

    def step(state, inp):
        qk_c, qd_c, kd_c, u_c, w_c, gl_c = inp
        v_new = u_c - jnp.einsum('bhck,bhkv->bhcv', w_c, state)
        o = jnp.einsum('bhck,bhkv->bhcv', qd_c, state) + jnp.einsum('bhij,bhjv->bhiv', qk_c, v_new)
        state = state * gl_c[..., None, None] + jnp.einsum('bhck,bhcv->bhkv', kd_c, v_new)
        return state, o

    s0 = jnp.zeros((b, h, dk, dv), f32)
    _, o = lax.scan(step, s0, xs)
    o = jnp.moveaxis(o, 0, 2).reshape(b, h, t, dv).transpose(0, 2, 1, 3)
    return o.astype(out_dtype)


def diff_attention(q, k, v, lam):
    b, s, h, _, dh = q.shape
    nb = s // Q_BLOCK
    scale = dh ** -0.5
    f32 = jnp.float32
    qb = q.astype(f32).reshape(b, nb, Q_BLOCK, h, 2, dh).transpose(1, 0, 3, 4, 2, 5)
    kt = k.astype(f32).transpose(0, 2, 3, 1, 4)
    vt = v.astype(f32).transpose(0, 2, 1, 3)

    def block(qblk):
        scores = jnp.einsum('bhcqd,bhckd->bhcqk', qblk, kt) * scale
        p = jax.nn.softmax(scores, axis=-1)
        a = p[:, :, 0] - lam * p[:, :, 1]
        return jnp.einsum('bhqk,bhke->bhqe', a, vt)

    o = lax.map(block, qb)
    o = o.transpose(1, 0, 3, 2, 4).reshape(b, s, h, 2 * dh)
    return o.astype(v.dtype)


def encoder_layer(x, pe, layer_idx, ln1_g, w_in, dn_conv_w, dn_a_log, dn_dt_bias, dn_norm_g,
                  da_qk_norm_g, da_lambda, da_subln_g, w_out, ln2_g, w_up, ffn_conv_w, ffn_conv_b,
                  w_down, ple_proj, ple_norm_g, ple_gate_norm_g, w_ple_gate):
    b, s, _ = x.shape
    lam_init = 0.8 - 0.6 * math.exp(-0.3 * layer_idx)

    hn = rms_norm(x, ln1_g)
    proj = hn @ w_in
    dq, dk, dv, dz, da, db, aq, ak, av = jnp.split(proj, SPLIT_IDX, axis=-1)

    qkv = jax.nn.silu(centred_dwconv(jnp.concatenate([dq, dk, dv], axis=-1), dn_conv_w))
    dq, dk, dv = jnp.split(qkv, [DN_QK, 2 * DN_QK], axis=-1)
    dq = (l2_norm(dq.reshape(b, s, N_DN, DK_DN).astype(jnp.float32)) * (DK_DN ** -0.5))
    dk = l2_norm(dk.reshape(b, s, N_DN, DK_DN).astype(jnp.float32))
    dv = dv.reshape(b, s, N_DN, DV_DN)
    da = da.reshape(b, s, 2, N_DN).astype(jnp.float32)
    db = db.reshape(b, s, 2, N_DN).astype(jnp.float32)
    log_decay = -jnp.exp(dn_a_log.astype(jnp.float32)) * jax.nn.softplus(da + dn_dt_bias.astype(jnp.float32))
    beta = jax.nn.sigmoid(db)
    o_fwd = gated_delta_rule(dq, dk, dv, log_decay[:, :, 0], beta[:, :, 0])
    flip = lambda a: jnp.flip(a, axis=1)
    o_bwd = flip(gated_delta_rule(flip(dq), flip(dk), flip(dv), flip(log_decay[:, :, 1]), flip(beta[:, :, 1])))
    o_dn = rms_norm(o_fwd + o_bwd, dn_norm_g) * jax.nn.silu(dz.reshape(b, s, N_DN, DV_DN))

    cos, sin = rope_tables(s)
    aq = partial_rope(rms_norm(aq.reshape(b, s, N_DA, 2, DH_DA), da_qk_norm_g[0]), cos, sin)
    ak = partial_rope(rms_norm(ak.reshape(b, s, N_DA, 2, DH_DA), da_qk_norm_g[1]), cos, sin)
    av = av.reshape(b, s, N_DA, 2 * DH_DA)
    lf = da_lambda.astype(jnp.float32)
    lam = jnp.exp(jnp.sum(lf[0] * lf[1])) - jnp.exp(jnp.sum(lf[2] * lf[3])) + lam_init
    o_da = diff_attention(aq, ak, av, lam)
    o_da = rms_norm(o_da, da_subln_g) * (1.0 - lam_init)

    mix = jnp.concatenate([o_dn.reshape(b, s, DN_V), o_da.reshape(b, s, DA_V)], axis=-1)
    x = x + (mix @ w_out).astype(x.dtype)

    hn = rms_norm(x, ln2_g)
    gate, up = jnp.split(hn @ w_up, [D_FF], axis=-1)
    gate = centred_dwconv(gate, ffn_conv_w) + ffn_conv_b
    x = x + ((jax.nn.silu(gate) * up) @ w_down).astype(x.dtype)

    e = rms_norm(pe @ ple_proj, ple_norm_g)
    gt = jax.nn.sigmoid(rms_norm(x, ple_gate_norm_g) @ w_ple_gate)
    return x + (gt * e).astype(x.dtype)


def trunk(x, p, weights):
    for i in range(DEPTH):
        x = encoder_layer(x, p[i], i, *[w[i] for w in weights])
    return x


def setup_inputs(seed: int = 0) -> dict:
    key = jax.random.key(seed)
    ks = jax.random.split(key, 24)
    f32 = jnp.float32
    nrm = lambda k, shape, scale: jax.random.normal(k, shape, f32) * scale
    gain = lambda k, shape: 1.0 + 0.02 * jax.random.normal(k, shape, f32)
    dt = jnp.exp(jax.random.uniform(ks[6], (DEPTH, 2, N_DN), f32, math.log(1e-3), math.log(1e-1)))
    return {
        "x_prompt": jax.random.normal(ks[0], (BATCH, SEQ, D_MODEL), f32),
        "x_sample": jax.random.normal(ks[1], (DEC_BATCH, DEC_SEQ, D_MODEL), f32),
        "p_prompt": jax.random.normal(ks[2], (DEPTH, BATCH, SEQ, PLE_DIM), f32),
        "p_sample": jax.random.normal(ks[3], (DEPTH, DEC_BATCH, DEC_SEQ, PLE_DIM), f32),
        "ln1_g": gain(ks[4], (DEPTH, D_MODEL)),
        "w_in": nrm(ks[5], (DEPTH, D_MODEL, IN_COLS), D_MODEL ** -0.5),
        "dn_conv_w": nrm(ks[7], (DEPTH, DN_CONV, 2 * DN_QK + DN_V), DN_CONV ** -0.5),
        "dn_a_log": jnp.log(jax.random.uniform(ks[8], (DEPTH, 2, N_DN), f32, 1.0, 16.0)),
        "dn_dt_bias": dt + jnp.log(-jnp.expm1(-dt)),
        "dn_norm_g": gain(ks[9], (DEPTH, DV_DN)),
        "da_qk_norm_g": gain(ks[10], (DEPTH, 2, DH_DA)),
        "da_lambda": nrm(ks[11], (DEPTH, 4, DH_DA), 0.1),
        "da_subln_g": gain(ks[12], (DEPTH, 2 * DH_DA)),
        "w_out": nrm(ks[13], (DEPTH, MIX_WIDTH, D_MODEL), MIX_WIDTH ** -0.5),
        "ln2_g": gain(ks[14], (DEPTH, D_MODEL)),
        "w_up": nrm(ks[15], (DEPTH, D_MODEL, 2 * D_FF), D_MODEL ** -0.5),
        "ffn_conv_w": nrm(ks[16], (DEPTH, FFN_CONV, D_FF), FFN_CONV ** -0.5),
        "ffn_conv_b": nrm(ks[17], (DEPTH, D_FF), 0.02),
        "w_down": nrm(ks[18], (DEPTH, D_FF, D_MODEL), D_FF ** -0.5),
        "ple_proj": nrm(ks[19], (DEPTH, PLE_DIM, D_MODEL), PLE_DIM ** -0.5),
        "ple_norm_g": gain(ks[20], (DEPTH, D_MODEL)),
        "ple_gate_norm_g": gain(ks[21], (DEPTH, D_MODEL)),
        "w_ple_gate": nrm(ks[22], (DEPTH, D_MODEL, D_MODEL), D_MODEL ** -0.5),
    }


def reference(x_prompt, x_sample, p_prompt, p_sample, ln1_g, w_in, dn_conv_w, dn_a_log, dn_dt_bias,
              dn_norm_g, da_qk_norm_g, da_lambda, da_subln_g, w_out, ln2_g, w_up, ffn_conv_w,
              ffn_conv_b, w_down, ple_proj, ple_norm_g, ple_gate_norm_g, w_ple_gate):
    weights = (ln1_g, w_in, dn_conv_w, dn_a_log, dn_dt_bias, dn_norm_g, da_qk_norm_g, da_lambda,
               da_subln_g, w_out, ln2_g, w_up, ffn_conv_w, ffn_conv_b, w_down, ple_proj,
               ple_norm_g, ple_gate_norm_g, w_ple_gate)
    y_prompt = trunk(x_prompt, p_prompt, weights)
    y_sample = trunk(x_sample, p_sample, weights)
    return (y_prompt, y_sample)
```

```cpp
#include <hip/hip_runtime.h>
#include <hip/hip_cooperative_groups.h>
#include <cstdio>
#include <cstdint>
namespace cg = cooperative_groups;

typedef unsigned short bf16_t;
typedef short bf16x8 __attribute__((ext_vector_type(8)));
typedef float f32x4 __attribute__((ext_vector_type(4)));
typedef unsigned u32x4 __attribute__((ext_vector_type(4)));
typedef unsigned u32x2 __attribute__((ext_vector_type(2)));

#ifndef COOP
#define COOP 1
#endif

constexpr int T = 81920, TP = 16384, DM = 1024, NPROJ = 3584, NIN = 3600, DFF = 2816, NUP = 5632, PLE = 256;
constexpr int NTHR = 512;
constexpr int NCHUNK = T / 64;
constexpr float EPS = 1e-6f;
constexpr int LDS_BYTES = 139264;

constexpr size_t OFF_CTL = 0;
constexpr size_t OFF_WIN = 4096;
constexpr size_t OFF_WOUT = OFF_WIN + (size_t)NPROJ * DM * 2;
constexpr size_t OFF_WUP = OFF_WOUT + (size_t)DM * DM * 2;
constexpr size_t OFF_WDN = OFF_WUP + (size_t)NUP * DM * 2;
constexpr size_t OFF_WPLE = OFF_WDN + (size_t)DM * DFF * 2;
constexpr size_t OFF_WG = OFF_WPLE + (size_t)DM * PLE * 2;
constexpr size_t OFF_DAB = OFF_WG + (size_t)DM * DM * 2;
constexpr size_t OFF_GC = OFF_DAB + (size_t)T * 16 * 4;
constexpr size_t OFF_SSQ = OFF_GC + (size_t)8 * T * 4;
constexpr size_t OFF_HN = OFF_SSQ + (size_t)T * 16 * 4;
constexpr size_t OFF_PROJ = OFF_HN + (size_t)T * DM * 2;
constexpr size_t OFF_QK = OFF_PROJ + (size_t)T * NPROJ * 2;
constexpr size_t WS_END = OFF_QK + (size_t)3 * T * 512 * 2;
constexpr size_t OFF_QN = OFF_QK;
constexpr size_t OFF_KN = OFF_QK + (size_t)T * 512 * 2;
constexpr size_t OFF_KNT = OFF_QK + (size_t)2 * T * 512 * 2;
constexpr size_t OFF_ERAW = OFF_QK;
constexpr size_t OFF_GE = OFF_ERAW + (size_t)T * DM * 2;
constexpr size_t OFF_UE = OFF_GE + (size_t)320 * 4 * DFF * 4;
constexpr size_t OFF_PE = OFF_UE + (size_t)320 * 2 * DFF * 4;
static_assert(OFF_PE + (size_t)T * PLE * 2 <= WS_END, "overlay");
static_assert(WS_END <= (size_t)1073741824, "ws");

struct Params {
    const float* xp; const float* xs; const float* pp; const float* ps;
    const float* ln1_g; const float* w_in; const float* dn_conv_w; const float* dn_a_log; const float* dn_dt_bias; const float* dn_norm_g;
    const float* da_qk_norm_g; const float* da_lambda; const float* da_subln_g; const float* w_out; const float* ln2_g; const float* w_up;
    const float* ffn_conv_w; const float* ffn_conv_b; const float* w_down; const float* ple_proj; const float* ple_norm_g; const float* ple_gate_norm_g; const float* w_ple_gate;
    float* out; unsigned char* ws;
    int ph_lo, ph_hi;
};

typedef float f32x2 __attribute__((ext_vector_type(2)));
typedef __bf16 bf16x2v __attribute__((ext_vector_type(2)));
__device__ __forceinline__ unsigned pk2(float lo, float hi) { const f32x2 v = {lo, hi}; const bf16x2v b = __builtin_convertvector(v, bf16x2v); return __builtin_bit_cast(unsigned, b); }
__device__ __forceinline__ float bflo(unsigned u) { return __uint_as_float(u << 16); }
__device__ __forceinline__ float bfhi(unsigned u) { return __uint_as_float(u & 0xffff0000u); }
__device__ __forceinline__ float bf2f(bf16_t h) { return __uint_as_float(((unsigned)h) << 16); }
__device__ __forceinline__ bf16_t f2bf(float f) { return (bf16_t)(pk2(f, 0.f) & 0xffffu); }
__device__ __forceinline__ float siluf(float x) { return x / (1.f + __expf(-x)); }
__device__ __forceinline__ float sigmoidf_(float x) { return 1.f / (1.f + __expf(-x)); }
__device__ __forceinline__ void tok_seq(int t, int& s0, int& S) { if (t < TP) { S = 2048; s0 = t & ~2047; } else { S = 4096; s0 = TP + ((t - TP) & ~4095); } }
__device__ __forceinline__ const float* xrow(const Params& p, int r) { return r < TP ? p.xp + (size_t)r * DM : p.xs + (size_t)(r - TP) * DM; }
__device__ __forceinline__ const float* prow(const Params& p, int r) { return r < TP ? p.pp + (size_t)r * PLE : p.ps + (size_t)(r - TP) * PLE; }
__device__ __forceinline__ float wave_sum(float v) {
#pragma unroll
    for (int o = 32; o >= 1; o >>= 1) v += __shfl_xor(v, o);
    return v;
}
#define MFMA16(a, b, c) __builtin_amdgcn_mfma_f32_16x16x32_bf16((a), (b), (c), 0, 0, 0)

__device__ void p0_weights(const Params& p) {
    extern __shared__ __attribute__((aligned(16))) unsigned char smem[];
    float* tile = (float*)smem;
    const int tid = threadIdx.x;
    const int n0 = 896, n1 = n0 + 256, n2 = n1 + 1408, n3 = n2 + 704, n4 = n3 + 64, n5 = n4 + 256;
    for (int tix = blockIdx.x; tix < n5; tix += gridDim.x) {
        const float* src; int ldsrc, K, mode, loc; bf16_t* dst;
        if (tix < n0) { src = p.w_in; ldsrc = NIN; K = DM; mode = 0; loc = tix; dst = (bf16_t*)(p.ws + OFF_WIN); }
        else if (tix < n1) { src = p.w_out; ldsrc = DM; K = DM; mode = 1; loc = tix - n0; dst = (bf16_t*)(p.ws + OFF_WOUT); }
        else if (tix < n2) { src = p.w_up; ldsrc = NUP; K = DM; mode = 2; loc = tix - n1; dst = (bf16_t*)(p.ws + OFF_WUP); }
        else if (tix < n3) { src = p.w_down; ldsrc = DM; K = DFF; mode = 1; loc = tix - n2; dst = (bf16_t*)(p.ws + OFF_WDN); }
        else if (tix < n4) { src = p.ple_proj; ldsrc = DM; K = PLE; mode = 1; loc = tix - n3; dst = (bf16_t*)(p.ws + OFF_WPLE); }
        else { src = p.w_ple_gate; ldsrc = DM; K = DM; mode = 1; loc = tix - n4; dst = (bf16_t*)(p.ws + OFF_WG); }
        const int nkt = K / 64, nt = loc / nkt, kt = loc % nkt;
        const int nbase = nt * 64;
        int cbase;
        if (mode == 0) cbase = nbase < 2048 ? nbase : nbase + 16;
        else if (mode == 2) { const int g = nbase >> 8, w = nbase & 255; cbase = (w < 128) ? g * 128 + w : DFF + g * 128 + (w - 128); }
        else cbase = nbase;
        const int c = tid & 63, r0 = tid >> 6;
#pragma unroll
        for (int i = 0; i < 8; ++i) { const int r = r0 + 8 * i; tile[r * 65 + c] = src[(size_t)(kt * 64 + r) * ldsrc + cbase + c]; }
        __syncthreads();
#pragma unroll
        for (int i = 0; i < 8; ++i) { const int n = r0 + 8 * i; dst[(size_t)(nbase + n) * K + kt * 64 + c] = f2bf(tile[c * 65 + n]); }
        __syncthreads();
    }
}

__device__ void p0_tokens(const Params& p) {
    extern __shared__ __attribute__((aligned(16))) unsigned char smem[];
    float* Wd = (float*)smem;
    const int tid = threadIdx.x, lane = tid & 63, wave = tid >> 6;
    for (int idx = tid; idx < 16384; idx += NTHR) { const int c = idx >> 4, k = idx & 15; Wd[k * 1024 + c] = p.w_in[(size_t)c * NIN + 2048 + k]; }
    __syncthreads();
    bf16_t* hn = (bf16_t*)(p.ws + OFF_HN);
    float* dab = (float*)(p.ws + OFF_DAB);
    for (int r = blockIdx.x * 8 + wave; r < T; r += gridDim.x * 8) {
        const float* xr = xrow(p, r);
        f32x4 v[4];
        float ss = 0.f;
#pragma unroll
        for (int i = 0; i < 4; ++i) { v[i] = *(const f32x4*)(xr + i * 256 + lane * 4); ss += v[i][0] * v[i][0] + v[i][1] * v[i][1] + v[i][2] * v[i][2] + v[i][3] * v[i][3]; }
        ss = wave_sum(ss);
        const float rs = rsqrtf(ss * (1.f / DM) + EPS);
#pragma unroll
        for (int i = 0; i < 4; ++i) {
            const f32x4 g = *(const f32x4*)(p.ln1_g + i * 256 + lane * 4);
            v[i] = v[i] * rs * g;
            u32x2 o; o[0] = pk2(v[i][0], v[i][1]); o[1] = pk2(v[i][2], v[i][3]);
            *(u32x2*)(hn + (size_t)r * DM + i * 256 + lane * 4) = o;
        }
        float myv = 0.f;
#pragma unroll 2
        for (int k = 0; k < 16; ++k) {
            float a = 0.f;
#pragma unroll
            for (int i = 0; i < 4; ++i) { const f32x4 w = *(const f32x4*)(Wd + k * 1024 + i * 256 + lane * 4); a += v[i][0] * w[0] + v[i][1] * w[1] + v[i][2] * w[2] + v[i][3] * w[3]; }
            a = wave_sum(a);
            if (lane == k) myv = a;
        }
        if (lane < 16) dab[(size_t)r * 16 + lane] = myv;
    }
    __syncthreads();
}

__device__ void rmsnorm_pass(const float* src, const float* g, bf16_t* hn) {
    const int tid = threadIdx.x, lane = tid & 63, wave = tid >> 6;
    for (int r = blockIdx.x * 8 + wave; r < T; r += gridDim.x * 8) {
        const float* xr = src + (size_t)r * DM;
        f32x4 v[4];
        float ss = 0.f;
#pragma unroll
        for (int i = 0; i < 4; ++i) { v[i] = *(const f32x4*)(xr + i * 256 + lane * 4); ss += v[i][0] * v[i][0] + v[i][1] * v[i][1] + v[i][2] * v[i][2] + v[i][3] * v[i][3]; }
        ss = wave_sum(ss);
        const float rs = rsqrtf(ss * (1.f / DM) + EPS);
#pragma unroll
        for (int i = 0; i < 4; ++i) {
            const f32x4 gg = *(const f32x4*)(g + i * 256 + lane * 4);
            v[i] = v[i] * rs * gg;
            u32x2 o; o[0] = pk2(v[i][0], v[i][1]); o[1] = pk2(v[i][2], v[i][3]);
            *(u32x2*)(hn + (size_t)r * DM + i * 256 + lane * 4) = o;
        }
    }
}

constexpr int BM = 256, BK = 64, HALF = 128, HT = HALF * BK;
__device__ __forceinline__ int lds_byte(int r, int c) { int st = (r >> 4) * 2 + (c >> 5), rr = r & 15, cc = c & 31, ob = rr * 64 + cc * 2; return st * 1024 + (ob ^ (((ob >> 9) & 1) << 5)); }
__device__ __forceinline__ void stage_rc(int b, int& R, int& C) { int st = b / 1024, sb = b % 1024, swz = sb ^ (((sb >> 9) & 1) << 5); R = (st >> 1) * 16 + swz / 64; C = (st & 1) * 32 + (swz % 64) / 2; }

#define LAS __attribute__((address_space(3)))
constexpr int HTB = HT * 2;
template <class Epi>
__device__ __forceinline__ void gemm_tile(const bf16_t* __restrict__ A, const int lda, const bf16_t* __restrict__ Bt, const int K, const int pm, const int pn, const Epi& epi) {
    extern __shared__ __attribute__((aligned(16))) unsigned char smem[];
    LAS unsigned char* lds = (LAS unsigned char*)smem;
    const int tid = threadIdx.x, wid = __builtin_amdgcn_readfirstlane(tid >> 6), lane = tid & 63, wr = wid >> 2, wc = wid & 3, fr = lane & 15, fq = lane >> 4;
    unsigned voffA[2], voffB[2];
#pragma unroll
    for (int i = 0; i < 2; ++i) { int R, C; stage_rc(tid * 16 + i * 8192, R, C); voffA[i] = (unsigned)(R * lda + C) * 2u; voffB[i] = (unsigned)(R * K + C) * 2u; }
    const unsigned ldsw = (unsigned)wid * 1024u;
    const int aoff = lds_byte(wr * 64 + fr, fq * 8), boff = lds_byte(wc * 32 + fr, fq * 8);
    const bf16_t* Ab0 = A + (size_t)(pm * BM) * lda;
    const bf16_t* Ab1 = Ab0 + (size_t)HALF * lda;
    const bf16_t* Bb0 = Bt + (size_t)(pn * BM) * K;
    const bf16_t* Bb1 = Bb0 + (size_t)HALF * K;
#define SA(b, h) (((b) * 2 + (h)) * HTB)
#define SB(b, h) ((4 + (b) * 2 + (h)) * HTB)
#define STAGE(bufoff, gbase, voff) do { _Pragma("unroll") for (int _i = 0; _i < 2; ++_i) \
      __builtin_amdgcn_global_load_lds((const unsigned*)((const char*)(gbase) + (voff)[_i]), (LAS unsigned*)(lds + (bufoff) + ldsw + _i * 8192), 16, 0, 0); } while (0)
#define STA(b, h, kt) STAGE(SA(b, h), ((h) ? Ab1 : Ab0) + (size_t)(kt) * BK, voffA)
#define STB(b, h, kt) STAGE(SB(b, h), ((h) ? Bb1 : Bb0) + (size_t)(kt) * BK, voffB)
#define LDA(dst, b, h) do { _Pragma("unroll") for (int m = 0; m < 4; ++m) _Pragma("unroll") for (int k = 0; k < 2; ++k) dst[m][k] = *(const LAS bf16x8*)(lds + SA(b, h) + aoff + m * 2048 + k * 1024); } while (0)
#define LDB(dst, b, h) do { _Pragma("unroll") for (int n = 0; n < 2; ++n) _Pragma("unroll") for (int k = 0; k < 2; ++k) dst[n][k] = *(const LAS bf16x8*)(lds + SB(b, h) + boff + n * 2048 + k * 1024); } while (0)
#define MMA(ai, bj, At_, Bt_) do { __builtin_amdgcn_s_setprio(1); \
    _Pragma("unroll") for (int m = 0; m < 4; ++m) _Pragma("unroll") for (int n = 0; n < 2; ++n) _Pragma("unroll") for (int k = 0; k < 2; ++k) \
      acc[ai][bj][m][n] = __builtin_amdgcn_mfma_f32_16x16x32_bf16(Bt_[n][k], At_[m][k], acc[ai][bj][m][n], 0, 0, 0); \
    __builtin_amdgcn_s_setprio(0); } while (0)
#define WAIT_V(n) asm volatile("s_waitcnt vmcnt(" #n ")" ::: "memory")
#define WAIT_L(n) asm volatile("s_waitcnt lgkmcnt(" #n ")" ::: "memory")
#define BAR __builtin_amdgcn_s_barrier()
#define SCHED __builtin_amdgcn_sched_barrier(0)
    f32x4 acc[2][2][4][2];
#pragma unroll
    for (int a = 0; a < 2; ++a)
#pragma unroll
        for (int b = 0; b < 2; ++b)
#pragma unroll
            for (int m = 0; m < 4; ++m)
#pragma unroll
                for (int n = 0; n < 2; ++n) acc[a][b][m][n] = (f32x4){0.f, 0.f, 0.f, 0.f};
    bf16x8 At[4][2], B0[2][2], B1[2][2];
    const int nt = K / BK;
    STB(0, 0, 0); STA(0, 0, 0);
    STB(0, 1, 0); STA(0, 1, 0);
    if (wr == 1) BAR;
    WAIT_V(4); BAR;
    STB(1, 0, 1); STA(1, 0, 1); STB(1, 1, 1);
    WAIT_V(6); BAR;
    for (int t = 0; t < nt - 2; t += 2) {
        LDB(B0, 0, 0); SCHED; LDA(At, 0, 0); STA(1, 1, t + 1);
        WAIT_L(8); BAR; WAIT_L(0); MMA(0, 0, At, B0); BAR; SCHED;
        LDB(B1, 0, 1); STB(0, 0, t + 2);
        BAR; WAIT_L(0); MMA(0, 1, At, B1); BAR;
        LDA(At, 0, 1); STA(0, 0, t + 2);
        BAR; WAIT_L(0); MMA(1, 0, At, B0); BAR; SCHED;
        STB(0, 1, t + 2);
        WAIT_V(6); BAR; MMA(1, 1, At, B1); BAR;
        LDB(B0, 1, 0); SCHED; LDA(At, 1, 0); STA(0, 1, t + 2);
        WAIT_L(8); BAR; WAIT_L(0); MMA(0, 0, At, B0); BAR; SCHED;
        LDB(B1, 1, 1); STB(1, 0, t + 3);
        BAR; WAIT_L(0); MMA(0, 1, At, B1); BAR;
        LDA(At, 1, 1); STA(1, 0, t + 3);
        BAR; WAIT_L(0); MMA(1, 0, At, B0); BAR; SCHED;
        STB(1, 1, t + 3);
        WAIT_V(6); BAR; MMA(1, 1, At, B1); BAR;
    }
    { LDB(B0, 0, 0); LDA(At, 0, 0); STA(1, 1, nt - 1);
      BAR; WAIT_L(0); MMA(0, 0, At, B0); BAR;
      LDB(B1, 0, 1); BAR; WAIT_L(0); MMA(0, 1, At, B1); BAR;
      LDA(At, 0, 1); WAIT_V(4); BAR; WAIT_L(0); MMA(1, 0, At, B0); MMA(1, 1, At, B1); BAR; }
    { LDB(B0, 1, 0); LDA(At, 1, 0); WAIT_V(2); BAR; WAIT_L(0); MMA(0, 0, At, B0); BAR;
      LDB(B1, 1, 1); WAIT_V(0); BAR; WAIT_L(0); MMA(0, 1, At, B1); BAR;
      LDA(At, 1, 1); BAR; WAIT_L(0); MMA(1, 0, At, B0); MMA(1, 1, At, B1); BAR; }
    if (wr == 0) BAR;
    epi(acc, pm, pn, wr, wc, fr, fq);
#undef SA
#undef SB
#undef STAGE
#undef STA
#undef STB
#undef LDA
#undef LDB
#undef MMA
}

template <class Epi>
__device__ __forceinline__ void gemm_phase(const bf16_t* A, int lda, const bf16_t* Bt, int M, int N, int K, const Epi& epi, int rot) {
    const int nM = M / BM, nN = N / BM, nwg = nM * nN;
    const int G = gridDim.x;
    const int c = (blockIdx.x + rot) % G;
    for (int L = c; L < nwg; L += G) {
        int wgid = L;
        { const int q = nwg / 8, r = nwg % 8, xcd = wgid % 8, off = wgid / 8; wgid = (xcd < r ? xcd * (q + 1) : r * (q + 1) + (xcd - r) * q) + off; }
        const int nig = 8 * nN, gid = wgid / nig, fm = gid * 8, gsz = (nM - fm) < 8 ? (nM - fm) : 8;
        const int pm = fm + ((wgid % nig) % gsz), pn = (wgid % nig) / gsz;
        gemm_tile<Epi>(A, lda, Bt, K, pm, pn, epi);
    }
}

typedef f32x4 AccT[2][2][4][2];

struct EpiProj {
    bf16_t* P;
    __device__ __forceinline__ void operator()(const AccT& acc, int pm, int pn, int wr, int wc, int fr, int fq) const {
#pragma unroll
        for (int ai = 0; ai < 2; ++ai)
#pragma unroll
            for (int m = 0; m < 4; ++m) {
                const int row = pm * 256 + ai * 128 + wr * 64 + m * 16 + fr;
#pragma unroll
                for (int bj = 0; bj < 2; ++bj)
#pragma unroll
                    for (int n = 0; n < 2; ++n) {
                        const int col = pn * 256 + bj * 128 + wc * 32 + n * 16 + fq * 4;
                        const f32x4 v = acc[ai][bj][m][n];
                        u32x2 o; o[0] = pk2(v[0], v[1]); o[1] = pk2(v[2], v[3]);
                        *(u32x2*)(P + (size_t)row * NPROJ + col) = o;
                    }
            }
    }
};

struct EpiResX {
    Params p;
    __device__ __forceinline__ void operator()(const AccT& acc, int pm, int pn, int wr, int wc, int fr, int fq) const {
#pragma unroll
        for (int ai = 0; ai < 2; ++ai)
#pragma unroll
            for (int m = 0; m < 4; ++m) {
                const int row = pm * 256 + ai * 128 + wr * 64 + m * 16 + fr;
                const float* xr = xrow(p, row);
#pragma unroll
                for (int bj = 0; bj < 2; ++bj)
#pragma unroll
                    for (int n = 0; n < 2; ++n) {
                        const int col = pn * 256 + bj * 128 + wc * 32 + n * 16 + fq * 4;
                        const f32x4 xv = *(const f32x4*)(xr + col);
                        *(f32x4*)(p.out + (size_t)row * DM + col) = xv + acc[ai][bj][m][n];
                    }
            }
    }
};

struct EpiAcc {
    float* out;
    __device__ __forceinline__ void operator()(const AccT& acc, int pm, int pn, int wr, int wc, int fr, int fq) const {
#pragma unroll
        for (int ai = 0; ai < 2; ++ai)
#pragma unroll
            for (int m = 0; m < 4; ++m) {
                const int row = pm * 256 + ai * 128 + wr * 64 + m * 16 + fr;
#pragma unroll
                for (int bj = 0; bj < 2; ++bj)
#pragma unroll
                    for (int n = 0; n < 2; ++n) {
                        const int col = pn * 256 + bj * 128 + wc * 32 + n * 16 + fq * 4;
                        float* o = out + (size_t)row * DM + col;
                        *(f32x4*)o = *(const f32x4*)o + acc[ai][bj][m][n];
                    }
            }
    }
};

struct EpiEraw {
    bf16_t* E; float* ssq;
    __device__ __forceinline__ void operator()(const AccT& acc, int pm, int pn, int wr, int wc, int fr, int fq) const {
#pragma unroll
        for (int ai = 0; ai < 2; ++ai)
#pragma unroll
            for (int m = 0; m < 4; ++m) {
                const int row = pm * 256 + ai * 128 + wr * 64 + m * 16 + fr;
                float s = 0.f;
#pragma unroll
                for (int bj = 0; bj < 2; ++bj)
#pragma unroll
                    for (int n = 0; n < 2; ++n) {
                        const int col = pn * 256 + bj * 128 + wc * 32 + n * 16 + fq * 4;
                        const f32x4 v = acc[ai][bj][m][n];
                        s += v[0] * v[0] + v[1] * v[1] + v[2] * v[2] + v[3] * v[3];
                        u32x2 o; o[0] = pk2(v[0], v[1]); o[1] = pk2(v[2], v[3]);
                        *(u32x2*)(E + (size_t)row * DM + col) = o;
                    }
                s += __shfl_xor(s, 16); s += __shfl_xor(s, 32);
                if (fq == 0) ssq[(size_t)row * 16 + pn * 4 + wc] = s;
            }
    }
};

struct EpiFinal {
    float* out; const bf16_t* E; const float* ssq; const float* ge;
    __device__ __forceinline__ void operator()(const AccT& acc, int pm, int pn, int wr, int wc, int fr, int fq) const {
#pragma unroll
        for (int ai = 0; ai < 2; ++ai)
#pragma unroll
            for (int m = 0; m < 4; ++m) {
                const int row = pm * 256 + ai * 128 + wr * 64 + m * 16 + fr;
                float s = 0.f;
#pragma unroll
                for (int q = 0; q < 4; ++q) { const f32x4 v = *(const f32x4*)(ssq + (size_t)row * 16 + q * 4); s += v[0] + v[1] + v[2] + v[3]; }
                const float rs = rsqrtf(s * (1.f / DM) + EPS);
#pragma unroll
                for (int bj = 0; bj < 2; ++bj)
#pragma unroll
                    for (int n = 0; n < 2; ++n) {
                        const int col = pn * 256 + bj * 128 + wc * 32 + n * 16 + fq * 4;
                        const u32x2 e = *(const u32x2*)(E + (size_t)row * DM + col);
                        const f32x4 g = *(const f32x4*)(ge + col);
                        const f32x4 a = acc[ai][bj][m][n];
                        f32x4 r;
                        r[0] = sigmoidf_(a[0]) * bflo(e[0]) * rs * g[0];
                        r[1] = sigmoidf_(a[1]) * bfhi(e[0]) * rs * g[1];
                        r[2] = sigmoidf_(a[2]) * bflo(e[1]) * rs * g[2];
                        r[3] = sigmoidf_(a[3]) * bfhi(e[1]) * rs * g[3];
                        float* o = out + (size_t)row * DM + col;
                        *(f32x4*)o = *(const f32x4*)o + r;
                    }
            }
    }
};

struct EpiFfn {
    bf16_t* H; float* ge; float* ue; const float* cw; const float* cb;
    __device__ __forceinline__ void operator()(const AccT& acc, int pm, int pn, int wr, int wc, int fr, int fq) const {
        extern __shared__ __attribute__((aligned(16))) unsigned char smem[];
        float* G = (float*)smem;
#pragma unroll
        for (int ai = 0; ai < 2; ++ai)
#pragma unroll
            for (int m = 0; m < 4; ++m) {
                const int r = ai * 128 + wr * 64 + m * 16 + fr;
#pragma unroll
                for (int n = 0; n < 2; ++n) *(f32x4*)(G + r * 132 + wc * 32 + n * 16 + fq * 4) = acc[ai][0][m][n];
            }
        __syncthreads();
#pragma unroll
        for (int n = 0; n < 2; ++n) {
            const int gc = wc * 32 + n * 16 + fq * 4;
            const int fc = pn * 128 + gc;
            const f32x4 w0 = *(const f32x4*)(cw + fc), w1 = *(const f32x4*)(cw + DFF + fc), w2 = *(const f32x4*)(cw + 2 * DFF + fc), bb = *(const f32x4*)(cb + fc);
#pragma unroll
            for (int ai = 0; ai < 2; ++ai)
#pragma unroll
                for (int m = 0; m < 4; ++m) {
                    const int r = ai * 128 + wr * 64 + m * 16 + fr;
                    const f32x4 gv = acc[ai][0][m][n], uv = acc[ai][1][m][n];
                    if (r == 0 || r == 255) {
                        *(f32x4*)(ge + ((size_t)pm * 4 + (r == 0 ? 0 : 3)) * DFF + fc) = gv;
                        *(f32x4*)(ue + ((size_t)pm * 2 + (r == 0 ? 0 : 1)) * DFF + fc) = uv;
                    } else {
                        if (r == 1) *(f32x4*)(ge + ((size_t)pm * 4 + 1) * DFF + fc) = gv;
                        if (r == 254) *(f32x4*)(ge + ((size_t)pm * 4 + 2) * DFF + fc) = gv;
                        const f32x4 gm = *(const f32x4*)(G + (r - 1) * 132 + gc), gp = *(const f32x4*)(G + (r + 1) * 132 + gc);
                        f32x4 hv;
#pragma unroll
                        for (int j = 0; j < 4; ++j) { const float cv = w0[j] * gm[j] + w1[j] * gv[j] + w2[j] * gp[j] + bb[j]; hv[j] = siluf(cv) * uv[j]; }
                        u32x2 o; o[0] = pk2(hv[0], hv[1]); o[1] = pk2(hv[2], hv[3]);
                        *(u32x2*)(H + (size_t)(pm * 256 + r) * DFF + fc) = o;
                    }
                }
        }
        __syncthreads();
    }
};

__device__ void ffn_edges(const Params& p) {
    bf16_t* H = (bf16_t*)(p.ws + OFF_PROJ);
    const float* ge = (const float*)(p.ws + OFF_GE);
    const float* ue = (const float*)(p.ws + OFF_UE);
    const int total = 320 * 2 * DFF;
    for (int idx = blockIdx.x * NTHR + threadIdx.x; idx < total; idx += gridDim.x * NTHR) {
        const int c = idx % DFF, e = (idx / DFF) & 1, pm = idx / (2 * DFF);
        const int tok = pm * 256 + (e ? 255 : 0);
        int s0, S; tok_seq(tok, s0, S);
        float gm, g0, gp, up;
        if (e == 0) {
            gm = (tok == s0) ? 0.f : ge[((size_t)(pm - 1) * 4 + 3) * DFF + c];
            g0 = ge[((size_t)pm * 4 + 0) * DFF + c]; gp = ge[((size_t)pm * 4 + 1) * DFF + c]; up = ue[((size_t)pm * 2 + 0) * DFF + c];
        } else {
            gm = ge[((size_t)pm * 4 + 2) * DFF + c]; g0 = ge[((size_t)pm * 4 + 3) * DFF + c];
            gp = (tok == s0 + S - 1) ? 0.f : ge[((size_t)(pm + 1) * 4 + 0) * DFF + c]; up = ue[((size_t)pm * 2 + 1) * DFF + c];
        }
        const float cv = p.ffn_conv_w[c] * gm + p.ffn_conv_w[DFF + c] * g0 + p.ffn_conv_w[2 * DFF + c] * gp + p.ffn_conv_b[c];
        H[(size_t)tok * DFF + c] = f2bf(siluf(cv) * up);
    }
}

__device__ void dn_prep_unit(const Params& p, int chunk, int h) {
    extern __shared__ __attribute__((aligned(16))) unsigned char smem[];
    bf16_t* Kb = (bf16_t*)smem;
    float* Kf = (float*)(smem + 17408);
    float* Vf = (float*)(smem + 50176);
    float* KK = (float*)(smem + 82944);
    float* Am = (float*)(smem + 99584);
    float* gs = (float*)(smem + 132352);
    float* bs = gs + 128;
    float* gcs = bs + 128;
    float* es = gcs + 128;
    const int tid = threadIdx.x, lane = tid & 63, wave = tid >> 6, fr = lane & 15, fq = lane >> 4;
    const bf16_t* proj = (const bf16_t*)(p.ws + OFF_PROJ);
    bf16_t* qn = (bf16_t*)(p.ws + OFF_QN);
    bf16_t* kn = (bf16_t*)(p.ws + OFF_KN);
    bf16_t* knt = (bf16_t*)(p.ws + OFF_KNT);
    const float* dab = (const float*)(p.ws + OFF_DAB);
    float* gcg = (float*)(p.ws + OFF_GC);
    bf16_t* ut = (bf16_t*)p.out;
    bf16_t* wrr = (bf16_t*)p.out + (size_t)10240 * 8192;
    const int tk0 = chunk * 64;
    int s0, S; tok_seq(tk0, s0, S);
    {
        const int rbase = tk0 + wave * 8;
#pragma unroll
        for (int mat = 0; mat < 3; ++mat) {
            const int colb = mat * 512 + h * 128 + 2 * lane;
            unsigned raw[12];
#pragma unroll
            for (int i = 0; i < 12; ++i) { const int t = rbase - 2 + i; raw[i] = (t >= s0 && t < s0 + S) ? *(const unsigned*)(proj + (size_t)t * NPROJ + colb) : 0u; }
            float cw0[5], cw1[5];
#pragma unroll
            for (int j = 0; j < 5; ++j) { cw0[j] = p.dn_conv_w[j * 1536 + colb]; cw1[j] = p.dn_conv_w[j * 1536 + colb + 1]; }
#pragma unroll
            for (int rr = 0; rr < 8; ++rr) {
                float o0 = 0.f, o1 = 0.f;
#pragma unroll
                for (int j = 0; j < 5; ++j) { o0 += cw0[j] * bflo(raw[rr + j]); o1 += cw1[j] * bfhi(raw[rr + j]); }
                o0 = siluf(o0); o1 = siluf(o1);
                const int row = wave * 8 + rr;
                if (mat < 2) {
                    float ss = wave_sum(o0 * o0 + o1 * o1);
                    float sc = rsqrtf(ss + EPS);
                    if (mat == 0) sc *= 0.08838834764831845f;
                    o0 *= sc; o1 *= sc;
                    const unsigned pk = pk2(o0, o1);
                    if (mat == 0) *(unsigned*)(qn + (size_t)(tk0 + row) * 512 + h * 128 + 2 * lane) = pk;
                    else {
                        *(unsigned*)(kn + (size_t)(tk0 + row) * 512 + h * 128 + 2 * lane) = pk;
                        *(unsigned*)(Kb + row * 136 + 2 * lane) = pk;
                        Kf[row * 128 + 2 * lane] = o0; Kf[row * 128 + 2 * lane + 1] = o1;
                    }
                } else { Vf[row * 128 + 2 * lane] = o0; Vf[row * 128 + 2 * lane + 1] = o1; }
            }
        }
        if (lane < 16) {
            const int rr = lane & 7, d = lane >> 3, row = wave * 8 + rr, t = tk0 + row;
            const float da = dab[(size_t)t * 16 + d * 4 + h], db = dab[(size_t)t * 16 + 8 + d * 4 + h];
            const float xx = da + p.dn_dt_bias[d * 4 + h];
            const float sp = fmaxf(xx, 0.f) + log1pf(__expf(-fabsf(xx)));
            gs[d * 64 + row] = -__expf(p.dn_a_log[d * 4 + h]) * sp;
            bs[d * 64 + row] = sigmoidf_(db);
        }
    }
    __syncthreads();
    if (wave < 2) {
        const int d = wave;
        float v = gs[d * 64 + lane];
#pragma unroll
        for (int off = 1; off < 64; off <<= 1) {
            const float tu = __shfl_up(v, off), td = __shfl_down(v, off);
            if (d == 0) { if (lane >= off) v += tu; } else { if (lane + off < 64) v += td; }
        }
        gcs[d * 64 + lane] = v;
        gcg[(size_t)(d * 4 + h) * T + tk0 + lane] = v;
    }
    {
        const int rt = wave & 3, ct0 = (wave >> 2) * 2;
#pragma unroll
        for (int cc = 0; cc < 2; ++cc) {
            const int ct = ct0 + cc;
            f32x4 a4 = {0.f, 0.f, 0.f, 0.f};
#pragma unroll
            for (int ks = 0; ks < 4; ++ks) {
                const bf16x8 a = *(const bf16x8*)(Kb + (rt * 16 + fr) * 136 + ks * 32 + fq * 8);
                const bf16x8 b = *(const bf16x8*)(Kb + (ct * 16 + fr) * 136 + ks * 32 + fq * 8);
                a4 = MFMA16(a, b, a4);
            }
#pragma unroll
            for (int j = 0; j < 4; ++j) KK[(rt * 16 + fq * 4 + j) * 65 + ct * 16 + fr] = a4[j];
        }
    }
    {
        const int dk = tid >> 2, piece = tid & 3;
        unsigned o[8];
#pragma unroll
        for (int e = 0; e < 8; ++e) o[e] = pk2(Kf[(piece * 16 + 2 * e) * 128 + dk], Kf[(piece * 16 + 2 * e + 1) * 128 + dk]);
        bf16_t* dst = knt + ((size_t)chunk * 4 + h) * 8192 + dk * 64 + piece * 16;
        *(u32x4*)dst = (u32x4){o[0], o[1], o[2], o[3]};
        *(u32x4*)(dst + 8) = (u32x4){o[4], o[5], o[6], o[7]};
    }
    __syncthreads();
    if (tid < 128) es[tid] = bs[tid] * __expf(gcs[tid]);
    for (int idx = tid; idx < 8192; idx += NTHR) {
        const int d = idx >> 12, ip = (idx >> 6) & 63, jp = idx & 63;
        const int ri = d ? 63 - ip : ip, rj = d ? 63 - jp : jp;
        float val = 0.f;
        if (jp < ip) val = bs[d * 64 + ri] * KK[ri * 65 + rj] * __expf(gcs[d * 64 + ri] - gcs[d * 64 + rj]);
        Am[idx] = val;
    }
    __syncthreads();
#ifndef NO_S5
    {
        const int d = __builtin_amdgcn_readfirstlane(tid >> 8), col = tid & 255;
        const bool isu = (__builtin_amdgcn_readfirstlane(tid >> 7) & 1) == 0;
        float x[64];
        if (isu) {
#pragma unroll
            for (int ip = 0; ip < 64; ++ip) { const int ri = d ? 63 - ip : ip; x[ip] = Vf[ri * 128 + col] * bs[d * 64 + ri]; }
        } else {
#pragma unroll
            for (int ip = 0; ip < 64; ++ip) { const int ri = d ? 63 - ip : ip; x[ip] = Kf[ri * 128 + (col - 128)] * es[d * 64 + ri]; }
        }
        const float* Ad = Am + d * 4096;
#ifndef NO_SOLVE
#pragma unroll
        for (int b = 0; b < 16; ++b) {
            float t0 = 0.f, t1 = 0.f, t2 = 0.f, t3 = 0.f;
#pragma unroll
            for (int q = 0; q < b; ++q) {
                const f32x4 a0 = *(const f32x4*)(Ad + (4 * b + 0) * 64 + q * 4), a1 = *(const f32x4*)(Ad + (4 * b + 1) * 64 + q * 4);
                const f32x4 a2 = *(const f32x4*)(Ad + (4 * b + 2) * 64 + q * 4), a3 = *(const f32x4*)(Ad + (4 * b + 3) * 64 + q * 4);
                t0 += a0[0] * x[4 * q] + a0[1] * x[4 * q + 1] + a0[2] * x[4 * q + 2] + a0[3] * x[4 * q + 3];
                t1 += a1[0] * x[4 * q] + a1[1] * x[4 * q + 1] + a1[2] * x[4 * q + 2] + a1[3] * x[4 * q + 3];
                t2 += a2[0] * x[4 * q] + a2[1] * x[4 * q + 1] + a2[2] * x[4 * q + 2] + a2[3] * x[4 * q + 3];
                t3 += a3[0] * x[4 * q] + a3[1] * x[4 * q + 1] + a3[2] * x[4 * q + 2] + a3[3] * x[4 * q + 3];
                if (q & 1) asm volatile("" ::: "memory");
            }
            const f32x4 d1 = *(const f32x4*)(Ad + (4 * b + 1) * 64 + b * 4), d2 = *(const f32x4*)(Ad + (4 * b + 2) * 64 + b * 4), d3 = *(const f32x4*)(Ad + (4 * b + 3) * 64 + b * 4);
            x[4 * b] -= t0;
            x[4 * b + 1] -= t1 + d1[0] * x[4 * b];
            x[4 * b + 2] -= t2 + d2[0] * x[4 * b] + d2[1] * x[4 * b + 1];
            x[4 * b + 3] -= t3 + d3[0] * x[4 * b] + d3[1] * x[4 * b + 1] + d3[2] * x[4 * b + 2];
            asm volatile("" ::: "memory");
        }
#endif
        const size_t uid = ((size_t)d * NCHUNK + chunk) * 4 + h;
        if (isu) {
            bf16_t* dst = ut + uid * 8192 + (size_t)col * 64;
            if (d == 0) {
#pragma unroll
                for (int r8 = 0; r8 < 8; ++r8)
                    *(u32x4*)(dst + r8 * 8) = (u32x4){pk2(x[r8 * 8], x[r8 * 8 + 1]), pk2(x[r8 * 8 + 2], x[r8 * 8 + 3]), pk2(x[r8 * 8 + 4], x[r8 * 8 + 5]), pk2(x[r8 * 8 + 6], x[r8 * 8 + 7])};
            } else {
#pragma unroll
                for (int r8 = 0; r8 < 8; ++r8)
                    *(u32x4*)(dst + r8 * 8) = (u32x4){pk2(x[63 - r8 * 8], x[62 - r8 * 8]), pk2(x[61 - r8 * 8], x[60 - r8 * 8]), pk2(x[59 - r8 * 8], x[58 - r8 * 8]), pk2(x[57 - r8 * 8], x[56 - r8 * 8])};
            }
        } else {
            bf16_t* dst = wrr + uid * 8192 + (col - 128) + (d ? 63 * 128 : 0);
            const int stride = d ? -128 : 128;
#pragma unroll
            for (int ip = 0; ip < 64; ++ip) dst[ip * stride] = f2bf(x[ip]);
        }
    }
#endif
    __syncthreads();
}

__device__ void attn_prep_unit(const Params& p, int chunk, int h) {
    extern __shared__ __attribute__((aligned(16))) unsigned char smem[];
    bf16_t* Vs = (bf16_t*)smem;
    const int tid = threadIdx.x;
    bf16_t* proj = (bf16_t*)(p.ws + OFF_PROJ);
    bf16_t* vt = (bf16_t*)(p.ws + OFF_HN);
    const int tk0 = chunk * 64;
    int s0, S; tok_seq(tk0, s0, S);
    const double INVF[8] = {0.15915494309189535, 0.03086376340470123, 0.005985185712713705, 0.001160663641240061,
                            0.00022507907903927653, 4.364795279280289e-05, 8.464330808241401e-06, 1.6414262627950345e-06};
#pragma unroll
    for (int it = 0; it < 4; ++it) {
        const int item = tid + NTHR * it, v = item >> 3, sub = item & 7;
        const int tokl = v >> 2, which = (v >> 1) & 1, c = v & 1;
        const int tok = tk0 + tokl;
        bf16_t* ptr = proj + (size_t)tok * NPROJ + 2048 + which * 512 + h * 128 + c * 64 + sub * 8;
        const u32x4 raw = *(const u32x4*)ptr;
        float f[8];
#pragma unroll
        for (int e = 0; e < 4; ++e) { f[2 * e] = bflo(raw[e]); f[2 * e + 1] = bfhi(raw[e]); }
        float ss = 0.f;
#pragma unroll
        for (int e = 0; e < 8; ++e) ss += f[e] * f[e];
        ss += __shfl_xor(ss, 1); ss += __shfl_xor(ss, 2); ss += __shfl_xor(ss, 4);
        const float rs = rsqrtf(ss * (1.f / 64.f) + EPS);
        float y[8], pr[8];
#pragma unroll
        for (int e = 0; e < 8; ++e) y[e] = f[e] * rs * p.da_qk_norm_g[which * 64 + sub * 8 + e];
#pragma unroll
        for (int e = 0; e < 8; ++e) pr[e] = __shfl_xor(y[e], 1);
        if (sub < 2) {
            const int pos = tok - s0;
#pragma unroll
            for (int e = 0; e < 8; ++e) {
                const double rr = (double)pos * INVF[e];
                const float fr_ = (float)(rr - floor(rr));
                const float sn = __builtin_amdgcn_sinf(fr_), cs = __builtin_amdgcn_cosf(fr_);
                y[e] = (sub == 0) ? (y[e] * cs - pr[e] * sn) : (y[e] * cs + pr[e] * sn);
            }
        }
        if (which == 0) {
#pragma unroll
            for (int e = 0; e < 8; ++e) y[e] *= 0.18033688011112042f;
        }
        *(u32x4*)ptr = (u32x4){pk2(y[0], y[1]), pk2(y[2], y[3]), pk2(y[4], y[5]), pk2(y[6], y[7])};
    }
#pragma unroll
    for (int it = 0; it < 2; ++it) {
        const int pi = tid + NTHR * it, row = pi >> 4, sub = pi & 15;
        const u32x4 raw = *(const u32x4*)(proj + (size_t)(tk0 + row) * NPROJ + 3072 + h * 128 + sub * 8);
        unsigned* d = (unsigned*)(Vs + row * 130 + sub * 8);
        d[0] = raw[0]; d[1] = raw[1]; d[2] = raw[2]; d[3] = raw[3];
    }
    __syncthreads();
#pragma unroll
    for (int it = 0; it < 2; ++it) {
        const int item = tid + NTHR * it, dv = item >> 3, piece = item & 7;
        unsigned o[4];
#pragma unroll
        for (int e = 0; e < 4; ++e) { const unsigned lo = Vs[(piece * 8 + 2 * e) * 130 + dv], hi = Vs[(piece * 8 + 2 * e + 1) * 130 + dv]; o[e] = lo | (hi << 16); }
        *(u32x4*)(vt + (size_t)s0 * 512 + (size_t)(h * 128 + dv) * S + (tk0 - s0) + piece * 8) = (u32x4){o[0], o[1], o[2], o[3]};
    }
    __syncthreads();
}

__device__ void dn_scan_unit(const Params& p, int u) {
    extern __shared__ __attribute__((aligned(16))) unsigned char smem[];
    bf16_t* Kb = (bf16_t*)smem;
    bf16_t* Vt = (bf16_t*)smem;
    bf16_t* Qb = (bf16_t*)(smem + 18432);
    bf16_t* QDb = (bf16_t*)(smem + 35840);
    bf16_t* KDt = (bf16_t*)(smem + 53248);
    bf16_t* Wb = (bf16_t*)(smem + 71680);
    bf16_t* St = (bf16_t*)(smem + 89088);
    bf16_t* QKm = (bf16_t*)(smem + 123904);
    float* gcs = (float*)(smem + 133120);
    const int tid = threadIdx.x, lane = tid & 63, wave = tid >> 6, fr = lane & 15, fq = lane >> 4;
    int sq, h, d;
    if (u < 128) { sq = 8 + (u >> 3); h = (u >> 1) & 3; d = u & 1; } else { const int u2 = u - 128; sq = u2 >> 3; h = (u2 >> 1) & 3; d = u2 & 1; }
    const int S = sq < 8 ? 2048 : 4096;
    const int s0 = sq < 8 ? sq * 2048 : TP + (sq - 8) * 4096;
    const int N = S / 64;
    const bf16_t* qn = (const bf16_t*)(p.ws + OFF_QN);
    const bf16_t* kn = (const bf16_t*)(p.ws + OFF_KN);
    const bf16_t* knt = (const bf16_t*)(p.ws + OFF_KNT);
    const float* gcg = (const float*)(p.ws + OFF_GC) + (size_t)(d * 4 + h) * T;
    const bf16_t* ut = (const bf16_t*)p.out;
    const bf16_t* wrr = (const bf16_t*)p.out + (size_t)10240 * 8192;
    bf16_t* proj = (bf16_t*)(p.ws + OFF_PROJ);
    f32x4 sacc[8];
#pragma unroll
    for (int i = 0; i < 8; ++i) sacc[i] = (f32x4){0.f, 0.f, 0.f, 0.f};
    for (int i = tid; i < 128 * 136 / 2; i += NTHR) ((unsigned*)St)[i] = 0u;
    __syncthreads();
    const int rt = wave & 3, cg4 = wave >> 2;
    for (int np = 0; np < N; ++np) {
        const int cis = d ? N - 1 - np : np;
        const int tk0 = s0 + cis * 64;
        const int chunkg = tk0 >> 6;
        const size_t uid = ((size_t)d * NCHUNK + chunkg) * 4 + h;
        const float gcl = gcg[tk0 + (d ? 0 : 63)];
#pragma unroll
        for (int it = 0; it < 2; ++it) {
            const int pi = tid + NTHR * it, row = pi >> 4, sub = pi & 15;
            const u32x4 kq = *(const u32x4*)(kn + (size_t)(tk0 + row) * 512 + h * 128 + sub * 8);
            const u32x4 qq = *(const u32x4*)(qn + (size_t)(tk0 + row) * 512 + h * 128 + sub * 8);
            const u32x4 ww = *(const u32x4*)(wrr + uid * 8192 + row * 128 + sub * 8);
            const float eg = __expf(gcg[tk0 + row]);
            *(u32x4*)(Kb + row * 136 + sub * 8) = kq;
            *(u32x4*)(Qb + row * 136 + sub * 8) = qq;
            *(u32x4*)(Wb + row * 136 + sub * 8) = ww;
            u32x4 qd;
#pragma unroll
            for (int e = 0; e < 4; ++e) qd[e] = pk2(bflo(qq[e]) * eg, bfhi(qq[e]) * eg);
            *(u32x4*)(QDb + row * 136 + sub * 8) = qd;
        }
#pragma unroll
        for (int it = 0; it < 2; ++it) {
            const int pi = tid + NTHR * it, dk = pi >> 3, piece = pi & 7;
            const u32x4 kk = *(const u32x4*)(knt + ((size_t)chunkg * 4 + h) * 8192 + dk * 64 + piece * 8);
            const f32x4 g0 = *(const f32x4*)(gcg + tk0 + piece * 8), g1 = *(const f32x4*)(gcg + tk0 + piece * 8 + 4);
            u32x4 o;
            o[0] = pk2(bflo(kk[0]) * __expf(gcl - g0[0]), bfhi(kk[0]) * __expf(gcl - g0[1]));
            o[1] = pk2(bflo(kk[1]) * __expf(gcl - g0[2]), bfhi(kk[1]) * __expf(gcl - g0[3]));
            o[2] = pk2(bflo(kk[2]) * __expf(gcl - g1[0]), bfhi(kk[2]) * __expf(gcl - g1[1]));
            o[3] = pk2(bflo(kk[3]) * __expf(gcl - g1[2]), bfhi(kk[3]) * __expf(gcl - g1[3]));
            *(u32x4*)(KDt + dk * 72 + piece * 8) = o;
        }
        if (tid < 64) gcs[tid] = gcg[tk0 + tid];
        __syncthreads();
        u32x2 uv[4];
#pragma unroll
        for (int c4 = 0; c4 < 4; ++c4) { const int ct = cg4 * 4 + c4; uv[c4] = *(const u32x2*)(ut + uid * 8192 + (size_t)(ct * 16 + fr) * 64 + rt * 16 + fq * 4); }
#pragma unroll
        for (int cc = 0; cc < 2; ++cc) {
            const int ct = cg4 * 2 + cc;
            f32x4 a4 = {0.f, 0.f, 0.f, 0.f};
#pragma unroll
            for (int ks = 0; ks < 4; ++ks) {
                const bf16x8 a = *(const bf16x8*)(Qb + (rt * 16 + fr) * 136 + ks * 32 + fq * 8);
                const bf16x8 b = *(const bf16x8*)(Kb + (ct * 16 + fr) * 136 + ks * 32 + fq * 8);
                a4 = MFMA16(a, b, a4);
            }
            const int jj = ct * 16 + fr;
            const float gj = gcs[jj];
#pragma unroll
            for (int j = 0; j < 4; ++j) {
                const int i = rt * 16 + fq * 4 + j;
                const bool keep = d ? (jj >= i) : (jj <= i);
                const float val = keep ? a4[j] * __expf(gcs[i] - gj) : 0.f;
                QKm[i * 72 + jj] = f2bf(val);
            }
        }
        f32x4 ws4[4], qs4[4];
#pragma unroll
        for (int c4 = 0; c4 < 4; ++c4) { ws4[c4] = (f32x4){0.f, 0.f, 0.f, 0.f}; qs4[c4] = (f32x4){0.f, 0.f, 0.f, 0.f}; }
#pragma unroll
        for (int ks = 0; ks < 4; ++ks) {
            const bf16x8 aw = *(const bf16x8*)(Wb + (rt * 16 + fr) * 136 + ks * 32 + fq * 8);
            const bf16x8 aq = *(const bf16x8*)(QDb + (rt * 16 + fr) * 136 + ks * 32 + fq * 8);
#pragma unroll
            for (int c4 = 0; c4 < 4; ++c4) {
                const int ct = cg4 * 4 + c4;
                const bf16x8 b = *(const bf16x8*)(St + (ct * 16 + fr) * 136 + ks * 32 + fq * 8);
                ws4[c4] = MFMA16(aw, b, ws4[c4]);
                qs4[c4] = MFMA16(aq, b, qs4[c4]);
            }
        }
        __syncthreads();
#pragma unroll
        for (int c4 = 0; c4 < 4; ++c4) {
            const int ct = cg4 * 4 + c4;
            const float v0 = bflo(uv[c4][0]) - ws4[c4][0], v1 = bfhi(uv[c4][0]) - ws4[c4][1], v2 = bflo(uv[c4][1]) - ws4[c4][2], v3 = bfhi(uv[c4][1]) - ws4[c4][3];
            u32x2 o; o[0] = pk2(v0, v1); o[1] = pk2(v2, v3);
            *(u32x2*)(Vt + (ct * 16 + fr) * 72 + rt * 16 + fq * 4) = o;
        }
        __syncthreads();
#pragma unroll
        for (int ks = 0; ks < 2; ++ks) {
            const bf16x8 a = *(const bf16x8*)(QKm + (rt * 16 + fr) * 72 + ks * 32 + fq * 8);
#pragma unroll
            for (int c4 = 0; c4 < 4; ++c4) {
                const int ct = cg4 * 4 + c4;
                const bf16x8 b = *(const bf16x8*)(Vt + (ct * 16 + fr) * 72 + ks * 32 + fq * 8);
                qs4[c4] = MFMA16(a, b, qs4[c4]);
            }
        }
#pragma unroll
        for (int c4 = 0; c4 < 4; ++c4) {
            const int ct = cg4 * 4 + c4;
#pragma unroll
            for (int j = 0; j < 4; ++j) proj[(size_t)(tk0 + rt * 16 + fq * 4 + j) * NPROJ + d * 512 + h * 128 + ct * 16 + fr] = f2bf(qs4[c4][j]);
        }
        const float gl = __expf(gcl);
#pragma unroll
        for (int c8 = 0; c8 < 8; ++c8) sacc[c8] = sacc[c8] * gl;
#pragma unroll
        for (int ks = 0; ks < 2; ++ks) {
            const bf16x8 a = *(const bf16x8*)(KDt + (wave * 16 + fr) * 72 + ks * 32 + fq * 8);
#pragma unroll
            for (int c8 = 0; c8 < 8; ++c8) {
                const bf16x8 b = *(const bf16x8*)(Vt + (c8 * 16 + fr) * 72 + ks * 32 + fq * 8);
                sacc[c8] = MFMA16(a, b, sacc[c8]);
            }
        }
#pragma unroll
        for (int c8 = 0; c8 < 8; ++c8) {
            u32x2 o; o[0] = pk2(sacc[c8][0], sacc[c8][1]); o[1] = pk2(sacc[c8][2], sacc[c8][3]);
            *(u32x2*)(St + (c8 * 16 + fr) * 136 + wave * 16 + fq * 4) = o;
        }
        __syncthreads();
    }
}

__device__ void attn_unit(const Params& p, int a, float lam) {
    extern __shared__ __attribute__((aligned(16))) unsigned char smem[];
    const int tid = threadIdx.x, lane = tid & 63, wave = tid >> 6, fr = lane & 15, fq = lane >> 4;
    int sq, h, qb;
    if (a < 2048) { sq = 8 + (a >> 7); const int rem = a & 127; h = rem >> 5; qb = rem & 31; }
    else { const int a2 = a - 2048; sq = a2 >> 6; const int rem = a2 & 63; h = rem >> 4; qb = rem & 15; }
    const int S = sq < 8 ? 2048 : 4096;
    const int s0 = sq < 8 ? sq * 2048 : TP + (sq - 8) * 4096;
    const int q0 = s0 + qb * 128, nt = S / 64;
    const int c = wave >> 2, wq = wave & 3;
    bf16_t* proj = (bf16_t*)(p.ws + OFF_PROJ);
    const bf16_t* vt = (const bf16_t*)(p.ws + OFF_HN) + (size_t)s0 * 512 + (size_t)h * 128 * S;
    bf16x8 qf[2][2];
#pragma unroll
    for (int rt = 0; rt < 2; ++rt)
#pragma unroll
        for (int ks = 0; ks < 2; ++ks)
            qf[rt][ks] = *(const bf16x8*)(proj + (size_t)(q0 + wq * 32 + rt * 16 + fr) * NPROJ + 2048 + h * 128 + c * 64 + ks * 32 + fq * 8);
    f32x4 ot[8][2];
#pragma unroll
    for (int dt = 0; dt < 8; ++dt) { ot[dt][0] = (f32x4){0.f, 0.f, 0.f, 0.f}; ot[dt][1] = (f32x4){0.f, 0.f, 0.f, 0.f}; }
    float mrow[2] = {-1e30f, -1e30f}, lrow[2] = {0.f, 0.f};
    const int kkey0 = tid >> 4, ksub = tid & 15;
    const int vdv0 = tid >> 3, vpiece = tid & 7;
    u32x4 kreg[2], vreg[2];
#define ATT_LOAD(t) do { _Pragma("unroll") for (int it = 0; it < 2; ++it) { \
        kreg[it] = *(const u32x4*)(proj + (size_t)(s0 + (t) * 64 + kkey0 + it * 32) * NPROJ + 2560 + h * 128 + ksub * 8); \
        vreg[it] = *(const u32x4*)(vt + (size_t)(vdv0 + it * 64) * S + (t) * 64 + vpiece * 8); } } while (0)
#define ATT_STORE(buf) do { bf16_t* Ks_ = (bf16_t*)(smem + (buf) * 36864); bf16_t* Vs_ = Ks_ + 9216; _Pragma("unroll") for (int it = 0; it < 2; ++it) { \
        *(u32x4*)(Ks_ + ((ksub >> 3) * 64 + kkey0 + it * 32) * 72 + (ksub & 7) * 8) = kreg[it]; \
        *(u32x4*)(Vs_ + (vdv0 + it * 64) * 72 + vpiece * 8) = vreg[it]; } } while (0)
    ATT_LOAD(0);
    ATT_STORE(0);
    __syncthreads();
    for (int t = 0; t < nt; ++t) {
        if (t + 1 < nt) ATT_LOAD(t + 1);
        const bf16_t* Ks = (const bf16_t*)(smem + (t & 1) * 36864);
        const bf16_t* Vs = Ks + 9216;
        f32x4 st[4][2];
#pragma unroll
        for (int kt = 0; kt < 4; ++kt) {
            st[kt][0] = (f32x4){0.f, 0.f, 0.f, 0.f}; st[kt][1] = (f32x4){0.f, 0.f, 0.f, 0.f};
#pragma unroll
            for (int ks = 0; ks < 2; ++ks) {
                const bf16x8 ka = *(const bf16x8*)(Ks + (c * 64 + kt * 16 + fr) * 72 + ks * 32 + fq * 8);
                st[kt][0] = MFMA16(ka, qf[0][ks], st[kt][0]);
                st[kt][1] = MFMA16(ka, qf[1][ks], st[kt][1]);
            }
        }
        bf16x8 pb[2][2];
#pragma unroll
        for (int rt = 0; rt < 2; ++rt) {
            float mx = -1e30f;
#pragma unroll
            for (int kt = 0; kt < 4; ++kt)
#pragma unroll
                for (int j = 0; j < 4; ++j) mx = fmaxf(mx, st[kt][rt][j]);
            mx = fmaxf(mx, __shfl_xor(mx, 16)); mx = fmaxf(mx, __shfl_xor(mx, 32));
            const float mnew = fmaxf(mrow[rt], mx);
            const float alpha = __builtin_amdgcn_exp2f(mrow[rt] - mnew);
            mrow[rt] = mnew;
            float ps = 0.f;
            float pv[4][4];
#pragma unroll
            for (int kt = 0; kt < 4; ++kt)
#pragma unroll
                for (int j = 0; j < 4; ++j) { pv[kt][j] = __builtin_amdgcn_exp2f(st[kt][rt][j] - mnew); ps += pv[kt][j]; }
            lrow[rt] = lrow[rt] * alpha + ps;
#pragma unroll
            for (int s = 0; s < 2; ++s) {
                u32x4 w;
                w[0] = pk2(pv[2 * s][0], pv[2 * s][1]); w[1] = pk2(pv[2 * s][2], pv[2 * s][3]);
                w[2] = pk2(pv[2 * s + 1][0], pv[2 * s + 1][1]); w[3] = pk2(pv[2 * s + 1][2], pv[2 * s + 1][3]);
                pb[rt][s] = __builtin_bit_cast(bf16x8, w);
            }
#pragma unroll
            for (int dt = 0; dt < 8; ++dt) ot[dt][rt] = ot[dt][rt] * alpha;
        }
#pragma unroll
        for (int dt = 0; dt < 8; ++dt)
#pragma unroll
            for (int s = 0; s < 2; ++s) {
                const u32x2 v0 = *(const u32x2*)(Vs + (dt * 16 + fr) * 72 + s * 32 + fq * 4);
                const u32x2 v1 = *(const u32x2*)(Vs + (dt * 16 + fr) * 72 + s * 32 + 16 + fq * 4);
                const bf16x8 va = __builtin_bit_cast(bf16x8, ((u32x4){v0[0], v0[1], v1[0], v1[1]}));
                ot[dt][0] = MFMA16(va, pb[0][s], ot[dt][0]);
                ot[dt][1] = MFMA16(va, pb[1][s], ot[dt][1]);
            }
        if (t + 1 < nt) ATT_STORE((t + 1) & 1);
        __syncthreads();
    }
#undef ATT_LOAD
#undef ATT_STORE
    float inv[2];
#pragma unroll
    for (int rt = 0; rt < 2; ++rt) { float l = lrow[rt]; l += __shfl_xor(l, 16); l += __shfl_xor(l, 32); inv[rt] = 1.f / l; }
    float* Ox = (float*)smem;
    if (c == 1) {
#pragma unroll
        for (int rt = 0; rt < 2; ++rt)
#pragma unroll
            for (int dt = 0; dt < 8; ++dt) *(f32x4*)(Ox + (wq * 32 + rt * 16 + fr) * 132 + dt * 16 + fq * 4) = ot[dt][rt] * inv[rt];
    }
    __syncthreads();
    if (c == 0) {
#pragma unroll
        for (int rt = 0; rt < 2; ++rt) {
            float ss = 0.f;
#pragma unroll
            for (int dt = 0; dt < 8; ++dt) {
                const f32x4 o2 = *(const f32x4*)(Ox + (wq * 32 + rt * 16 + fr) * 132 + dt * 16 + fq * 4);
                ot[dt][rt] = ot[dt][rt] * inv[rt] - lam * o2;
                ss += ot[dt][rt][0] * ot[dt][rt][0] + ot[dt][rt][1] * ot[dt][rt][1] + ot[dt][rt][2] * ot[dt][rt][2] + ot[dt][rt][3] * ot[dt][rt][3];
            }
            ss += __shfl_xor(ss, 16); ss += __shfl_xor(ss, 32);
            const float rs = rsqrtf(ss * (1.f / 128.f) + EPS) * 0.8f;
            const int row = q0 + wq * 32 + rt * 16 + fr;
#pragma unroll
            for (int dt = 0; dt < 8; ++dt) {
                const f32x4 g = *(const f32x4*)(p.da_subln_g + dt * 16 + fq * 4);
                const f32x4 v = ot[dt][rt] * rs * g;
                u32x2 o; o[0] = pk2(v[0], v[1]); o[1] = pk2(v[2], v[3]);
                *(u32x2*)(proj + (size_t)row * NPROJ + 2048 + h * 128 + dt * 16 + fq * 4) = o;
            }
        }
    }
    __syncthreads();
}

__device__ void dn_combine(const Params& p) {
    bf16_t* proj = (bf16_t*)(p.ws + OFF_PROJ);
    const int tid = threadIdx.x, lane = tid & 63, wave = tid >> 6;
    for (int t = blockIdx.x * 8 + wave; t < T; t += gridDim.x * 8) {
        bf16_t* row = proj + (size_t)t * NPROJ;
        const u32x4 a = *(const u32x4*)(row + lane * 8), b = *(const u32x4*)(row + 512 + lane * 8), z = *(const u32x4*)(row + 1536 + lane * 8);
        float s[8], zz[8];
#pragma unroll
        for (int e = 0; e < 4; ++e) { s[2 * e] = bflo(a[e]) + bflo(b[e]); s[2 * e + 1] = bfhi(a[e]) + bfhi(b[e]); zz[2 * e] = bflo(z[e]); zz[2 * e + 1] = bfhi(z[e]); }
        float ss = 0.f;
#pragma unroll
        for (int e = 0; e < 8; ++e) ss += s[e] * s[e];
        ss += __shfl_xor(ss, 1); ss += __shfl_xor(ss, 2); ss += __shfl_xor(ss, 4); ss += __shfl_xor(ss, 8);
        const float rs = rsqrtf(ss * (1.f / 128.f) + EPS);
        float y[8];
#pragma unroll
        for (int e = 0; e < 8; ++e) y[e] = s[e] * rs * p.dn_norm_g[(lane * 8 + e) & 127] * siluf(zz[e]);
        *(u32x4*)(row + 1536 + lane * 8) = (u32x4){pk2(y[0], y[1]), pk2(y[2], y[3]), pk2(y[4], y[5]), pk2(y[6], y[7])};
    }
}

__device__ void pe_convert(const Params& p) {
    bf16_t* pe = (bf16_t*)(p.ws + OFF_PE);
    const size_t total = (size_t)T * PLE / 4;
    for (size_t i = (size_t)blockIdx.x * NTHR + threadIdx.x; i < total; i += (size_t)gridDim.x * NTHR) {
        const int r = (int)(i >> 6), c4 = (int)(i & 63);
        const f32x4 v = *(const f32x4*)(prow(p, r) + c4 * 4);
        u32x2 o; o[0] = pk2(v[0], v[1]); o[1] = pk2(v[2], v[3]);
        *(u32x2*)(pe + (size_t)r * PLE + c4 * 4) = o;
    }
}


#ifndef DUMP_MODE
#define DUMP_MODE 6
#endif
__device__ void dump_phase(const Params& p) {
    const bf16_t* proj = (const bf16_t*)(p.ws + OFF_PROJ);
    const bf16_t* hn = (const bf16_t*)(p.ws + OFF_HN);
    const bf16_t* qk = (const bf16_t*)(p.ws + OFF_QK);
    const float* dab = (const float*)(p.ws + OFF_DAB);
    const float* gc = (const float*)(p.ws + OFF_GC);
    const size_t total = (size_t)T * DM;
    for (size_t i = (size_t)blockIdx.x * NTHR + threadIdx.x; i < total; i += (size_t)gridDim.x * NTHR) {
        const size_t t = i >> 10; const int c = (int)(i & 1023);
        float v = 1.f;
        if (DUMP_MODE == 1) v += bf2f(hn[i]) + dab[t * 16 + (c & 15)];
        if (DUMP_MODE == 2 || DUMP_MODE == 3) { v += bf2f(proj[t * NPROJ + c]) + bf2f(proj[t * NPROJ + 1024 + c]) + bf2f(proj[t * NPROJ + 2048 + c]); if (c < 512) v += bf2f(proj[t * NPROJ + 3072 + c]); }
        if (DUMP_MODE == 3) {
            v += bf2f(qk[i]);
            if (c < 512) v += bf2f(qk[total + t * 512 + c]);
            if (c < 512) v += bf2f(hn[t * 512 + c]);
            if (c < 8) v += gc[(size_t)c * T + t];
            const unsigned w = ((const unsigned*)p.out)[i];
            v += bflo(w) + bfhi(w);
        }
        if (DUMP_MODE == 4) { v += 100.f * bf2f(proj[t * NPROJ + c]); }
        if (DUMP_MODE == 5) { v += 100.f * bf2f(qk[i]); if (c < 512) v += 100.f * bf2f(qk[total + t * 512 + c]) + bf2f(hn[t * 512 + c]); if (c < 8) v += gc[(size_t)c * T + t]; v += bf2f(proj[t * NPROJ + 2048 + c]); }
        if (DUMP_MODE == 6) { const unsigned w = ((const unsigned*)p.out)[i]; v += fminf(fmaxf(bflo(w) + bfhi(w), -8.f), 8.f); }
        p.out[i] = v;
    }
}

__global__ void __launch_bounds__(NTHR, 2) fwd_kernel(Params p) {
    extern __shared__ __attribute__((aligned(16))) unsigned char smem[];
    cg::grid_group grid = cg::this_grid();
    const int lo = p.ph_lo, hi = p.ph_hi;
#ifndef ONLY
#define ONLY -1
#endif
#define IN(k) ((ONLY < 0 || ONLY == (k)) && lo <= (k) && (k) < hi)
#define SYNC(k) do { if (IN(k) && IN((k) + 1)) grid.sync(); } while (0)
    unsigned* ctl = (unsigned*)(p.ws + OFF_CTL);
    if (IN(0)) { p0_weights(p); p0_tokens(p); }
    SYNC(0);
    if (IN(1)) { EpiProj e{(bf16_t*)(p.ws + OFF_PROJ)}; gemm_phase<EpiProj>((const bf16_t*)(p.ws + OFF_HN), DM, (const bf16_t*)(p.ws + OFF_WIN), T, NPROJ, DM, e, 0); }
    SYNC(1);
    if (IN(2)) {
        for (int u = blockIdx.x; u < 2 * NCHUNK * 4; u += gridDim.x) {
            if (u < NCHUNK * 4) dn_prep_unit(p, u >> 2, u & 3); else { const int v = u - NCHUNK * 4; attn_prep_unit(p, v >> 2, v & 3); }
        }
    }
    SYNC(2);
    if (IN(3)) {
        for (int u = blockIdx.x; u < 192; u += gridDim.x) dn_scan_unit(p, u);
        float l01 = 0.f, l23 = 0.f;
        for (int i = 0; i < 64; ++i) { l01 += p.da_lambda[i] * p.da_lambda[64 + i]; l23 += p.da_lambda[128 + i] * p.da_lambda[192 + i]; }
        const float lam = __expf(l01) - __expf(l23) + 0.2f;
        int* sh = (int*)(smem + LDS_BYTES - 16);
        while (true) {
            __syncthreads();
            if (threadIdx.x == 0) *sh = (int)atomicAdd(ctl, 1u);
            __syncthreads();
            const int a = *sh;
            if (a >= 2560) break;
#ifndef SKIP_ATTN
            attn_unit(p, a, lam);
#endif
        }
    }
    SYNC(3);
    if (IN(4)) dn_combine(p);
    SYNC(4);
    if (IN(5)) { EpiResX e{p}; gemm_phase<EpiResX>((const bf16_t*)(p.ws + OFF_PROJ) + 1536, NPROJ, (const bf16_t*)(p.ws + OFF_WOUT), T, DM, DM, e, 0); }
    SYNC(5);
    if (IN(6)) { rmsnorm_pass(p.out, p.ln2_g, (bf16_t*)(p.ws + OFF_HN)); pe_convert(p); }
    SYNC(6);
    if (IN(7)) {
        EpiFfn e{(bf16_t*)(p.ws + OFF_PROJ), (float*)(p.ws + OFF_GE), (float*)(p.ws + OFF_UE), p.ffn_conv_w, p.ffn_conv_b};
        gemm_phase<EpiFfn>((const bf16_t*)(p.ws + OFF_HN), DM, (const bf16_t*)(p.ws + OFF_WUP), T, NUP, DM, e, 0);
        EpiEraw e2{(bf16_t*)(p.ws + OFF_ERAW), (float*)(p.ws + OFF_SSQ)};
        gemm_phase<EpiEraw>((const bf16_t*)(p.ws + OFF_PE), PLE, (const bf16_t*)(p.ws + OFF_WPLE), T, DM, PLE, e2, 128);
    }
    SYNC(7);
    if (IN(8)) ffn_edges(p);
    SYNC(8);
    if (IN(9)) { EpiAcc e{p.out}; gemm_phase<EpiAcc>((const bf16_t*)(p.ws + OFF_PROJ), DFF, (const bf16_t*)(p.ws + OFF_WDN), T, DM, DFF, e, 0); }
    SYNC(9);
    if (IN(10)) rmsnorm_pass(p.out, p.ple_gate_norm_g, (bf16_t*)(p.ws + OFF_HN));
    SYNC(10);
    if (IN(11)) {
        EpiFinal e{p.out, (const bf16_t*)(p.ws + OFF_ERAW), (const float*)(p.ws + OFF_SSQ), p.ple_norm_g};
        gemm_phase<EpiFinal>((const bf16_t*)(p.ws + OFF_HN), DM, (const bf16_t*)(p.ws + OFF_WG), T, DM, DM, e, 0);
    }
#ifdef DUMP_ON
    if (IN(12)) dump_phase(p);
#endif
#undef IN
#undef SYNC
}

constexpr int NPHASE = 12;

extern "C" void kernel_launch(void* const* d_in, const int* in_sizes, int n_in, void* d_out, int out_size, void* d_ws, size_t ws_size, hipStream_t stream) {
    static int grid = 0;
    if (grid == 0) {
        if (n_in != 23 || ws_size < WS_END) { fprintf(stderr, "kernel_launch: unexpected n_in %d / ws %zu (need %zu)\n", n_in, ws_size, (size_t)WS_END); grid = -1; return; }
        int dev = 0, cus = 0, per_cu = 0;
        hipGetDevice(&dev);
        hipDeviceGetAttribute(&cus, hipDeviceAttributeMultiprocessorCount, dev);
        if (hipFuncSetAttribute((const void*)fwd_kernel, hipFuncAttributeMaxDynamicSharedMemorySize, LDS_BYTES) != hipSuccess) { fprintf(stderr, "kernel_launch: hipFuncSetAttribute failed\n"); grid = -1; return; }
        if (hipOccupancyMaxActiveBlocksPerMultiprocessor(&per_cu, (const void*)fwd_kernel, NTHR, LDS_BYTES) != hipSuccess || per_cu < 1) { fprintf(stderr, "kernel_launch: occupancy query says %d\n", per_cu); per_cu = 1; }
        (void)hipGetLastError();
        grid = cus * per_cu;
    }
    if (grid < 0) return;
    hipMemsetAsync((char*)d_ws + OFF_CTL, 0, 4096, stream);
    Params p{};
    p.xp = (const float*)d_in[0]; p.xs = (const float*)d_in[1]; p.pp = (const float*)d_in[2]; p.ps = (const float*)d_in[3];
    p.ln1_g = (const float*)d_in[4]; p.w_in = (const float*)d_in[5]; p.dn_conv_w = (const float*)d_in[6]; p.dn_a_log = (const float*)d_in[7];
    p.dn_dt_bias = (const float*)d_in[8]; p.dn_norm_g = (const float*)d_in[9]; p.da_qk_norm_g = (const float*)d_in[10]; p.da_lambda = (const float*)d_in[11];
    p.da_subln_g = (const float*)d_in[12]; p.w_out = (const float*)d_in[13]; p.ln2_g = (const float*)d_in[14]; p.w_up = (const float*)d_in[15];
    p.ffn_conv_w = (const float*)d_in[16]; p.ffn_conv_b = (const float*)d_in[17]; p.w_down = (const float*)d_in[18]; p.ple_proj = (const float*)d_in[19];
    p.ple_norm_g = (const float*)d_in[20]; p.ple_gate_norm_g = (const float*)d_in[21]; p.w_ple_gate = (const float*)d_in[22];
    p.out = (float*)d_out; p.ws = (unsigned char*)d_ws;
#if COOP
    p.ph_lo = 0; p.ph_hi = NPHASE;
    void* args[] = {&p};
    hipError_t e = hipLaunchCooperativeKernel((const void*)fwd_kernel, dim3(grid), dim3(NTHR), args, LDS_BYTES, stream);
    if (e != hipSuccess) fprintf(stderr, "cooperative launch failed: %s (grid %d)\n", hipGetErrorString(e), grid);
#else
#ifndef PH_LIMIT
#define PH_LIMIT NPHASE
#endif
    for (int ph = 0; ph < PH_LIMIT; ++ph) {
        p.ph_lo = ph; p.ph_hi = ph + 1;
        hipLaunchKernelGGL(fwd_kernel, dim3(grid), dim3(NTHR), LDS_BYTES, stream, p);
    }
#ifdef DUMP_ON
    p.ph_lo = 12; p.ph_hi = 13;
    hipLaunchKernelGGL(fwd_kernel, dim3(grid), dim3(NTHR), LDS_BYTES, stream, p);
#endif
#endif
}
```

```cpp
#include <hip/hip_runtime.h>
#include <hip/hip_cooperative_groups.h>
#include <cstdio>
#include <cstdint>
namespace cg = cooperative_groups;

typedef unsigned short bf16_t;
typedef short bf16x8 __attribute__((ext_vector_type(8)));
typedef float f32x4 __attribute__((ext_vector_type(4)));
typedef unsigned u32x4 __attribute__((ext_vector_type(4)));
typedef unsigned u32x2 __attribute__((ext_vector_type(2)));

#ifndef COOP
#define COOP 1
#endif

constexpr int T = 81920, TP = 16384, DM = 1024, NPROJ = 3584, NIN = 3600, DFF = 2816, NUP = 5632, PLE = 256;
constexpr int NTHR = 512;
constexpr int NCHUNK = T / 64;
constexpr float EPS = 1e-6f;
constexpr int LDS_BYTES = 139264;

constexpr size_t OFF_CTL = 0;
constexpr size_t OFF_WIN = 4096;
constexpr size_t OFF_WOUT = OFF_WIN + (size_t)NPROJ * DM * 2;
constexpr size_t OFF_WUP = OFF_WOUT + (size_t)DM * DM * 2;
constexpr size_t OFF_WDN = OFF_WUP + (size_t)NUP * DM * 2;
constexpr size_t OFF_WPLE = OFF_WDN + (size_t)DM * DFF * 2;
constexpr size_t OFF_WG = OFF_WPLE + (size_t)DM * PLE * 2;
constexpr size_t OFF_DAB = OFF_WG + (size_t)DM * DM * 2;
constexpr size_t OFF_GC = OFF_DAB + (size_t)T * 16 * 4;
constexpr size_t OFF_SSQ = OFF_GC + (size_t)8 * T * 4;
constexpr size_t OFF_HN = OFF_SSQ + (size_t)T * 16 * 4;
constexpr size_t OFF_PROJ = OFF_HN + (size_t)T * DM * 2;
constexpr size_t OFF_QK = OFF_PROJ + (size_t)T * NPROJ * 2;
constexpr size_t WS_END = OFF_QK + (size_t)3 * T * 512 * 2;
constexpr size_t OFF_QN = OFF_QK;
constexpr size_t OFF_KN = OFF_QK + (size_t)T * 512 * 2;
constexpr size_t OFF_KNT = OFF_QK + (size_t)2 * T * 512 * 2;
constexpr size_t OFF_ERAW = OFF_QK;
constexpr size_t OFF_GE = OFF_ERAW + (size_t)T * DM * 2;
constexpr size_t OFF_UE = OFF_GE + (size_t)320 * 4 * DFF * 4;
constexpr size_t OFF_PE = OFF_UE + (size_t)320 * 2 * DFF * 4;
static_assert(OFF_PE + (size_t)T * PLE * 2 <= WS_END, "overlay");
constexpr size_t OFF_BAR = WS_END;
static_assert(OFF_BAR + 16384 <= (size_t)1073741824, "ws");

struct Params {
    const float* xp; const float* xs; const float* pp; const float* ps;
    const float* ln1_g; const float* w_in; const float* dn_conv_w; const float* dn_a_log; const float* dn_dt_bias; const float* dn_norm_g;
    const float* da_qk_norm_g; const float* da_lambda; const float* da_subln_g; const float* w_out; const float* ln2_g; const float* w_up;
    const float* ffn_conv_w; const float* ffn_conv_b; const float* w_down; const float* ple_proj; const float* ple_norm_g; const float* ple_gate_norm_g; const float* w_ple_gate;
    float* out; unsigned char* ws;
    int ph_lo, ph_hi;
};

typedef float f32x2 __attribute__((ext_vector_type(2)));
typedef __bf16 bf16x2v __attribute__((ext_vector_type(2)));
__device__ __forceinline__ unsigned pk2(float lo, float hi) { const f32x2 v = {lo, hi}; const bf16x2v b = __builtin_convertvector(v, bf16x2v); return __builtin_bit_cast(unsigned, b); }
__device__ __forceinline__ float bflo(unsigned u) { return __uint_as_float(u << 16); }
__device__ __forceinline__ float bfhi(unsigned u) { return __uint_as_float(u & 0xffff0000u); }
__device__ __forceinline__ float bf2f(bf16_t h) { return __uint_as_float(((unsigned)h) << 16); }
__device__ __forceinline__ bf16_t f2bf(float f) { return (bf16_t)(pk2(f, 0.f) & 0xffffu); }
__device__ __forceinline__ float siluf(float x) { return x / (1.f + __expf(-x)); }
__device__ __forceinline__ float sigmoidf_(float x) { return 1.f / (1.f + __expf(-x)); }
__device__ __forceinline__ void tok_seq(int t, int& s0, int& S) { if (t < TP) { S = 2048; s0 = t & ~2047; } else { S = 4096; s0 = TP + ((t - TP) & ~4095); } }
__device__ __forceinline__ const float* xrow(const Params& p, int r) { return r < TP ? p.xp + (size_t)r * DM : p.xs + (size_t)(r - TP) * DM; }
__device__ __forceinline__ const float* prow(const Params& p, int r) { return r < TP ? p.pp + (size_t)r * PLE : p.ps + (size_t)(r - TP) * PLE; }
__device__ __forceinline__ float wave_sum(float v) {
#pragma unroll
    for (int o = 32; o >= 1; o >>= 1) v += __shfl_xor(v, o);
    return v;
}
#define MFMA16(a, b, c) __builtin_amdgcn_mfma_f32_16x16x32_bf16((a), (b), (c), 0, 0, 0)

__device__ void p0_weights(const Params& p) {
    extern __shared__ __attribute__((aligned(16))) unsigned char smem[];
    float* tile = (float*)smem;
    const int tid = threadIdx.x;
    const int n0 = 896, n1 = n0 + 256, n2 = n1 + 1408, n3 = n2 + 704, n4 = n3 + 64, n5 = n4 + 256;
    for (int tix = blockIdx.x; tix < n5; tix += gridDim.x) {
        const float* src; int ldsrc, K, mode, loc; bf16_t* dst;
        if (tix < n0) { src = p.w_in; ldsrc = NIN; K = DM; mode = 0; loc = tix; dst = (bf16_t*)(p.ws + OFF_WIN); }
        else if (tix < n1) { src = p.w_out; ldsrc = DM; K = DM; mode = 1; loc = tix - n0; dst = (bf16_t*)(p.ws + OFF_WOUT); }
        else if (tix < n2) { src = p.w_up; ldsrc = NUP; K = DM; mode = 2; loc = tix - n1; dst = (bf16_t*)(p.ws + OFF_WUP); }
        else if (tix < n3) { src = p.w_down; ldsrc = DM; K = DFF; mode = 1; loc = tix - n2; dst = (bf16_t*)(p.ws + OFF_WDN); }
        else if (tix < n4) { src = p.ple_proj; ldsrc = DM; K = PLE; mode = 1; loc = tix - n3; dst = (bf16_t*)(p.ws + OFF_WPLE); }
        else { src = p.w_ple_gate; ldsrc = DM; K = DM; mode = 1; loc = tix - n4; dst = (bf16_t*)(p.ws + OFF_WG); }
        const int nkt = K / 64, nt = loc / nkt, kt = loc % nkt;
        const int nbase = nt * 64;
        int cbase;
        if (mode == 0) cbase = nbase < 2048 ? nbase : nbase + 16;
        else if (mode == 2) { const int g = nbase >> 8, w = nbase & 255; cbase = (w < 128) ? g * 128 + w : DFF + g * 128 + (w - 128); }
        else cbase = nbase;
        const int c = tid & 63, r0 = tid >> 6;
#pragma unroll
        for (int i = 0; i < 8; ++i) { const int r = r0 + 8 * i; tile[r * 65 + c] = src[(size_t)(kt * 64 + r) * ldsrc + cbase + c]; }
        __syncthreads();
#pragma unroll
        for (int i = 0; i < 8; ++i) { const int n = r0 + 8 * i;
            const int rho = n & 31, ii = rho & 15, ns = (n & 32) + 8 * (ii >> 2) + 4 * (rho >> 4) + (ii & 3);
            dst[(size_t)(nbase + n) * K + kt * 64 + c] = f2bf(tile[c * 65 + ns]); }
        __syncthreads();
    }
}

__device__ void p0_tokens(const Params& p) {
    extern __shared__ __attribute__((aligned(16))) unsigned char smem[];
    float* Wd = (float*)smem;
    const int tid = threadIdx.x, lane = tid & 63, wave = tid >> 6;
    for (int idx = tid; idx < 16384; idx += NTHR) { const int c = idx >> 4, k = idx & 15; Wd[k * 1024 + c] = p.w_in[(size_t)c * NIN + 2048 + k]; }
    __syncthreads();
    bf16_t* hn = (bf16_t*)(p.ws + OFF_HN);
    float* dab = (float*)(p.ws + OFF_DAB);
    const int step = gridDim.x * 8;
    f32x4 vn[2][4];
    {
#pragma unroll
        for (int q = 0; q < 2; ++q) { const int r = blockIdx.x * 8 + wave + q * step; if (r < T) { const float* xr = xrow(p, r);
#pragma unroll
            for (int i = 0; i < 4; ++i) vn[q][i] = *(const f32x4*)(xr + i * 256 + lane * 4); } }
    }
    f32x4 g1[4];
#pragma unroll
    for (int i = 0; i < 4; ++i) g1[i] = *(const f32x4*)(p.ln1_g + i * 256 + lane * 4);
    for (int r0 = blockIdx.x * 8 + wave; r0 < T; r0 += 2 * step) {
        f32x4 v[2][4];
        float ss[2] = {0.f, 0.f};
#pragma unroll
        for (int q = 0; q < 2; ++q)
#pragma unroll
            for (int i = 0; i < 4; ++i) { v[q][i] = vn[q][i]; ss[q] += v[q][i][0] * v[q][i][0] + v[q][i][1] * v[q][i][1] + v[q][i][2] * v[q][i][2] + v[q][i][3] * v[q][i][3]; }
#pragma unroll
        for (int q = 0; q < 2; ++q) { const int rn = r0 + (2 + q) * step; if (rn < T) { const float* xr = xrow(p, rn);
#pragma unroll
            for (int i = 0; i < 4; ++i) vn[q][i] = *(const f32x4*)(xr + i * 256 + lane * 4); } }
        const bool has1 = (r0 + step) < T;
#pragma unroll
        for (int q = 0; q < 2; ++q) {
            ss[q] = wave_sum(ss[q]);
            const float rs = rsqrtf(ss[q] * (1.f / DM) + EPS);
            const int r = r0 + q * step;
#pragma unroll
            for (int i = 0; i < 4; ++i) {
                v[q][i] = v[q][i] * rs * g1[i];
                if (q == 0 || has1) { u32x2 o; o[0] = pk2(v[q][i][0], v[q][i][1]); o[1] = pk2(v[q][i][2], v[q][i][3]); *(u32x2*)(hn + (size_t)r * DM + i * 256 + lane * 4) = o; }
            }
        }
        float my0 = 0.f, my1 = 0.f;
#pragma unroll 2
        for (int k = 0; k < 16; ++k) {
            float a0 = 0.f, a1 = 0.f;
#pragma unroll
            for (int i = 0; i < 4; ++i) { const f32x4 w = *(const f32x4*)(Wd + k * 1024 + i * 256 + lane * 4);
                a0 += v[0][i][0] * w[0] + v[0][i][1] * w[1] + v[0][i][2] * w[2] + v[0][i][3] * w[3];
                a1 += v[1][i][0] * w[0] + v[1][i][1] * w[1] + v[1][i][2] * w[2] + v[1][i][3] * w[3]; }
            a0 = wave_sum(a0); a1 = wave_sum(a1);
            if (lane == k) { my0 = a0; my1 = a1; }
        }
        if (lane < 16) { dab[(size_t)r0 * 16 + lane] = my0; if (has1) dab[(size_t)(r0 + step) * 16 + lane] = my1; }
    }
    __syncthreads();
}

__device__ void rmsnorm_pass(const float* src, const float* g, bf16_t* hn) {
    const int tid = threadIdx.x, lane = tid & 63, wave = tid >> 6;
    constexpr int RB = 4;
    f32x4 gg[4];
#pragma unroll
    for (int i = 0; i < 4; ++i) gg[i] = *(const f32x4*)(g + (i >> 1) * 512 + lane * 8 + (i & 1) * 4);
    for (int r0 = (blockIdx.x * 8 + wave) * RB; r0 < T; r0 += gridDim.x * 8 * RB) {
        f32x4 v[RB][4];
#pragma unroll
        for (int k = 0; k < RB; ++k)
#pragma unroll
            for (int i = 0; i < 4; ++i) v[k][i] = *(const f32x4*)(src + (size_t)(r0 + k) * DM + (i >> 1) * 512 + lane * 8 + (i & 1) * 4);
#pragma unroll
        for (int k = 0; k < RB; ++k) {
            float ss = 0.f;
#pragma unroll
            for (int i = 0; i < 4; ++i) ss += v[k][i][0] * v[k][i][0] + v[k][i][1] * v[k][i][1] + v[k][i][2] * v[k][i][2] + v[k][i][3] * v[k][i][3];
            ss = wave_sum(ss);
            const float rs = rsqrtf(ss * (1.f / DM) + EPS);
#pragma unroll
            for (int hh = 0; hh < 2; ++hh) {
                const f32x4 y0 = v[k][2 * hh] * rs * gg[2 * hh], y1 = v[k][2 * hh + 1] * rs * gg[2 * hh + 1];
                *(u32x4*)(hn + (size_t)(r0 + k) * DM + hh * 512 + lane * 8) = (u32x4){pk2(y0[0], y0[1]), pk2(y0[2], y0[3]), pk2(y1[0], y1[1]), pk2(y1[2], y1[3])};
            }
        }
    }
}

constexpr int BM = 256, BK = 64, HALF = 128, HT = HALF * BK;
__device__ __forceinline__ int lds_byte(int r, int c) { int st = (r >> 4) * 2 + (c >> 5), rr = r & 15, cc = c & 31, ob = rr * 64 + cc * 2; return st * 1024 + (ob ^ (((ob >> 9) & 1) << 5)); }
__device__ __forceinline__ void stage_rc(int b, int& R, int& C) { int st = b / 1024, sb = b % 1024, swz = sb ^ (((sb >> 9) & 1) << 5); R = (st >> 1) * 16 + swz / 64; C = (st & 1) * 32 + (swz % 64) / 2; }

#define LAS __attribute__((address_space(3)))
constexpr int HTB = HT * 2;
template <class Epi>
__device__ __forceinline__ void gemm_tile(const bf16_t* __restrict__ A, const int lda, const bf16_t* __restrict__ Bt, const int K, const int pm, const int pn, const Epi& epi) {
    extern __shared__ __attribute__((aligned(16))) unsigned char smem[];
    LAS unsigned char* lds = (LAS unsigned char*)smem;
    const int tid = threadIdx.x, wid = __builtin_amdgcn_readfirstlane(tid >> 6), lane = tid & 63, wr = wid >> 2, wc = wid & 3, fr = lane & 15, fq = lane >> 4;
    unsigned voffA[2], voffB[2];
#pragma unroll
    for (int i = 0; i < 2; ++i) { int R, C; stage_rc(tid * 16 + i * 8192, R, C); voffA[i] = (unsigned)(R * lda + C) * 2u; voffB[i] = (unsigned)(R * K + C) * 2u; }
    const unsigned ldsw = (unsigned)wid * 1024u;
    const int aoff = lds_byte(wr * 64 + fr, fq * 8), boff = lds_byte(wc * 32 + fr, fq * 8);
    const bf16_t* Ab0 = A + (size_t)(pm * BM) * lda;
    const bf16_t* Ab1 = Ab0 + (size_t)HALF * lda;
    const bf16_t* Bb0 = Bt + (size_t)(pn * BM) * K;
    const bf16_t* Bb1 = Bb0 + (size_t)HALF * K;
#define SA(b, h) (((b) * 2 + (h)) * HTB)
#define SB(b, h) ((4 + (b) * 2 + (h)) * HTB)
#define STAGE(bufoff, gbase, voff) do { _Pragma("unroll") for (int _i = 0; _i < 2; ++_i) \
      __builtin_amdgcn_global_load_lds((const unsigned*)((const char*)(gbase) + (voff)[_i]), (LAS unsigned*)(lds + (bufoff) + ldsw + _i * 8192), 16, 0, 0); } while (0)
#define STA(b, h, kt) STAGE(SA(b, h), ((h) ? Ab1 : Ab0) + (size_t)(kt) * BK, voffA)
#define STB(b, h, kt) STAGE(SB(b, h), ((h) ? Bb1 : Bb0) + (size_t)(kt) * BK, voffB)
#define LDA(dst, b, h) do { _Pragma("unroll") for (int m = 0; m < 4; ++m) _Pragma("unroll") for (int k = 0; k < 2; ++k) dst[m][k] = *(const LAS bf16x8*)(lds + SA(b, h) + aoff + m * 2048 + k * 1024); } while (0)
#define LDB(dst, b, h) do { _Pragma("unroll") for (int n = 0; n < 2; ++n) _Pragma("unroll") for (int k = 0; k < 2; ++k) dst[n][k] = *(const LAS bf16x8*)(lds + SB(b, h) + boff + n * 2048 + k * 1024); } while (0)
#define MMA(ai, bj, At_, Bt_) do { __builtin_amdgcn_s_setprio(1); \
    _Pragma("unroll") for (int m = 0; m < 4; ++m) _Pragma("unroll") for (int n = 0; n < 2; ++n) _Pragma("unroll") for (int k = 0; k < 2; ++k) \
      acc[ai][bj][m][n] = __builtin_amdgcn_mfma_f32_16x16x32_bf16(Bt_[n][k], At_[m][k], acc[ai][bj][m][n], 0, 0, 0); \
    __builtin_amdgcn_s_setprio(0); } while (0)
#define WAIT_V(n) asm volatile("s_waitcnt vmcnt(" #n ")" ::: "memory")
#define WAIT_L(n) asm volatile("s_waitcnt lgkmcnt(" #n ")" ::: "memory")
#define BAR __builtin_amdgcn_s_barrier()
#define SCHED __builtin_amdgcn_sched_barrier(0)
    f32x4 acc[2][2][4][2];
#pragma unroll
    for (int a = 0; a < 2; ++a)
#pragma unroll
        for (int b = 0; b < 2; ++b)
#pragma unroll
            for (int m = 0; m < 4; ++m)
#pragma unroll
                for (int n = 0; n < 2; ++n) acc[a][b][m][n] = (f32x4){0.f, 0.f, 0.f, 0.f};
    bf16x8 At[4][2], B0[2][2], B1[2][2];
    const int nt = K / BK;
    STB(0, 0, 0); STA(0, 0, 0);
    STB(0, 1, 0); STA(0, 1, 0);
    if (wr == 1) BAR;
    WAIT_V(4); BAR;
    STB(1, 0, 1); STA(1, 0, 1); STB(1, 1, 1);
    WAIT_V(6); BAR;
    for (int t = 0; t < nt - 2; t += 2) {
        LDB(B0, 0, 0); SCHED; LDA(At, 0, 0); STA(1, 1, t + 1);
        WAIT_L(8); BAR; WAIT_L(0); MMA(0, 0, At, B0); BAR; SCHED;
        LDB(B1, 0, 1); STB(0, 0, t + 2);
        BAR; WAIT_L(0); MMA(0, 1, At, B1); BAR;
        LDA(At, 0, 1); STA(0, 0, t + 2);
        BAR; WAIT_L(0); MMA(1, 0, At, B0); BAR; SCHED;
        STB(0, 1, t + 2);
        WAIT_V(6); BAR; MMA(1, 1, At, B1); BAR;
        LDB(B0, 1, 0); SCHED; LDA(At, 1, 0); STA(0, 1, t + 2);
        WAIT_L(8); BAR; WAIT_L(0); MMA(0, 0, At, B0); BAR; SCHED;
        LDB(B1, 1, 1); STB(1, 0, t + 3);
        BAR; WAIT_L(0); MMA(0, 1, At, B1); BAR;
        LDA(At, 1, 1); STA(1, 0, t + 3);
        BAR; WAIT_L(0); MMA(1, 0, At, B0); BAR; SCHED;
        STB(1, 1, t + 3);
        WAIT_V(6); BAR; MMA(1, 1, At, B1); BAR;
    }
    { LDB(B0, 0, 0); LDA(At, 0, 0); STA(1, 1, nt - 1);
      BAR; WAIT_L(0); MMA(0, 0, At, B0); BAR;
      LDB(B1, 0, 1); BAR; WAIT_L(0); MMA(0, 1, At, B1); BAR;
      LDA(At, 0, 1); WAIT_V(4); BAR; WAIT_L(0); MMA(1, 0, At, B0); MMA(1, 1, At, B1); BAR; }
    { LDB(B0, 1, 0); LDA(At, 1, 0); WAIT_V(2); BAR; WAIT_L(0); MMA(0, 0, At, B0); BAR;
      LDB(B1, 1, 1); WAIT_V(0); BAR; WAIT_L(0); MMA(0, 1, At, B1); BAR;
      LDA(At, 1, 1); BAR; WAIT_L(0); MMA(1, 0, At, B0); MMA(1, 1, At, B1); BAR; }
    if (wr == 0) BAR;
    epi(acc, pm, pn, wr, wc, fr, fq);
#undef SA
#undef SB
#undef STAGE
#undef STA
#undef STB
#undef LDA
#undef LDB
#undef MMA
}

__device__ __forceinline__ bool tile_of(int L, int nM, int nN, int& pm, int& pn) {
    const int nwg = nM * nN;
    if (L >= nwg) return false;
    int wgid = L;
    { const int q = nwg / 8, r = nwg % 8, xcd = wgid % 8, off = wgid / 8; wgid = (xcd < r ? xcd * (q + 1) : r * (q + 1) + (xcd - r) * q) + off; }
    const int nig = 8 * nN, gid = wgid / nig, fm = gid * 8, gsz = (nM - fm) < 8 ? (nM - fm) : 8;
    pm = fm + ((wgid % nig) % gsz); pn = (wgid % nig) / gsz;
    return true;
}

template <class Epi>
__device__ __forceinline__ void gemm_phase(const bf16_t* A, int lda, const bf16_t* Bt, int M, int N, int K, const Epi& epi, int rot) {
    const int nM = M / BM, nN = N / BM;
    const int G = gridDim.x;
    int c = (int)blockIdx.x + rot; if (c >= G) c -= G;
    for (int L = c; ; L += G) {
        int pm, pn;
        if (!tile_of(L, nM, nN, pm, pn)) break;
        gemm_tile<Epi>(A, lda, Bt, K, pm, pn, epi);
    }
}

template <class Epi, bool PACKA = false>
__device__ __forceinline__ void gemm_phase_p(const bf16_t* __restrict__ A, const int lda, const bf16_t* __restrict__ Bt, int M, int N, const int K, const Epi& epi, int rot) {
    extern __shared__ __attribute__((aligned(16))) unsigned char smem[];
    LAS unsigned char* lds = (LAS unsigned char*)smem;
    const int nM = M / BM, nN = N / BM;
    const int G = gridDim.x;
    int c = (int)blockIdx.x + rot; if (c >= G) c -= G;
    int pm, pn, npm, npn;
    if (!tile_of(c, nM, nN, pm, pn)) return;
    const int tid = threadIdx.x, wid = __builtin_amdgcn_readfirstlane(tid >> 6), lane = tid & 63, wr = wid >> 2, wc = wid & 3, fr = lane & 15, fq = lane >> 4;
    unsigned voffA[2], voffB[2];
#pragma unroll
    for (int i = 0; i < 2; ++i) { int R, C; stage_rc(tid * 16 + i * 8192, R, C); voffA[i] = (unsigned)(R * (PACKA ? 64 : lda) + C) * 2u; voffB[i] = (unsigned)(R * K + C) * 2u; }
    const unsigned ldsw = (unsigned)wid * 1024u;
    const int aoff = lds_byte(wr * 64 + fr, fq * 8), boff = lds_byte(wc * 32 + fr, fq * 8);
    const int nt = K / BK;
    const size_t kstep = (size_t)BK * 2, kA = PACKA ? (size_t)256 * 64 * 2 : kstep, hA = PACKA ? (size_t)HALF * 64 * 2 : (size_t)HALF * lda * 2, hB = (size_t)HALF * K * 2,
                 tA = PACKA ? (size_t)nt * 256 * 64 * 2 : 2 * hA, tB = 2 * hB;
#define SA(b, h) (((b) * 2 + (h)) * HTB)
#define SB(b, h) ((4 + (b) * 2 + (h)) * HTB)
#define STAGE(bufoff, gbase, voff) do { _Pragma("unroll") for (int _i = 0; _i < 2; ++_i) \
      __builtin_amdgcn_global_load_lds((const unsigned*)((const char*)(gbase) + (voff)[_i]), (LAS unsigned*)(lds + (bufoff) + ldsw + _i * 8192), 16, 0, 0); } while (0)
#define LDA(dst, b, h) do { _Pragma("unroll") for (int m = 0; m < 4; ++m) _Pragma("unroll") for (int k = 0; k < 2; ++k) dst[m][k] = *(const LAS bf16x8*)(lds + SA(b, h) + aoff + m * 2048 + k * 1024); } while (0)
#define LDB(dst, b, h) do { _Pragma("unroll") for (int n = 0; n < 2; ++n) _Pragma("unroll") for (int k = 0; k < 2; ++k) dst[n][k] = *(const LAS bf16x8*)(lds + SB(b, h) + boff + n * 2048 + k * 1024); } while (0)
#define MMA(ai, bj, At_, Bt_) do { __builtin_amdgcn_s_setprio(1); \
    _Pragma("unroll") for (int m = 0; m < 4; ++m) _Pragma("unroll") for (int n = 0; n < 2; ++n) _Pragma("unroll") for (int k = 0; k < 2; ++k) \
      acc[ai][bj][m][n] = __builtin_amdgcn_mfma_f32_16x16x32_bf16(Bt_[n][k], At_[m][k], acc[ai][bj][m][n], 0, 0, 0); \
    __builtin_amdgcn_s_setprio(0); } while (0)
    f32x4 acc[2][2][4][2];
#pragma unroll
    for (int a = 0; a < 2; ++a)
#pragma unroll
        for (int b = 0; b < 2; ++b)
#pragma unroll
            for (int m = 0; m < 4; ++m)
#pragma unroll
                for (int n = 0; n < 2; ++n) acc[a][b][m][n] = (f32x4){0.f, 0.f, 0.f, 0.f};
    bf16x8 At[4][2], B0[2][2], B1[2][2];
    const char* cA = (const char*)A + (size_t)pm * tA; const char* cB = (const char*)Bt + (size_t)pn * tB;
    STAGE(SB(0, 0), cB, voffB); STAGE(SA(0, 0), cA, voffA); STAGE(SB(0, 1), cB + hB, voffB); STAGE(SA(0, 1), cA + hA, voffA);
    if (wr == 1) BAR;
    WAIT_V(4); BAR;
    STAGE(SB(1, 0), cB + kstep, voffB); STAGE(SA(1, 0), cA + kA, voffA); STAGE(SB(1, 1), cB + hB + kstep, voffB);
    WAIT_V(6); BAR;
    int L = c;
    for (;;) {
        const bool has_next = tile_of(L + G, nM, nN, npm, npn);
        const char* nA = has_next ? (const char*)A + (size_t)npm * tA : cA; const char* nB = has_next ? (const char*)Bt + (size_t)npn * tB : cB;
        for (int t = 0; t < nt; t += 2) {
            const bool last = (t == nt - 2);
            const char* a1 = cA + (size_t)(t + 1) * kA;
            const char* a2 = last ? nA : cA + (size_t)(t + 2) * kA; const char* b2 = last ? nB : cB + (size_t)(t + 2) * kstep;
            const char* a3 = a2 + kA; const char* b3 = b2 + kstep;
            LDB(B0, 0, 0); SCHED; LDA(At, 0, 0); STAGE(SA(1, 1), a1 + hA, voffA);
            WAIT_L(8); BAR; WAIT_L(0); MMA(0, 0, At, B0); BAR; SCHED;
            LDB(B1, 0, 1); STAGE(SB(0, 0), b2, voffB);
            BAR; WAIT_L(0); MMA(0, 1, At, B1); BAR;
            LDA(At, 0, 1); STAGE(SA(0, 0), a2, voffA);
            BAR; WAIT_L(0); MMA(1, 0, At, B0); BAR; SCHED;
            STAGE(SB(0, 1), b2 + hB, voffB);
            WAIT_V(6); BAR; MMA(1, 1, At, B1); BAR;
            LDB(B0, 1, 0); SCHED; LDA(At, 1, 0); STAGE(SA(0, 1), a2 + hA, voffA);
            WAIT_L(8); BAR; WAIT_L(0); MMA(0, 0, At, B0); BAR; SCHED;
            LDB(B1, 1, 1); STAGE(SB(1, 0), b3, voffB);
            BAR; WAIT_L(0); MMA(0, 1, At, B1); BAR;
            LDA(At, 1, 1); STAGE(SA(1, 0), a3, voffA);
            BAR; WAIT_L(0); MMA(1, 0, At, B0); BAR; SCHED;
            STAGE(SB(1, 1), b3 + hB, voffB);
            WAIT_V(6); BAR; MMA(1, 1, At, B1); BAR;
        }
        epi(acc, pm, pn, wr, wc, fr, fq);
        if (!has_next) break;
#pragma unroll
        for (int a = 0; a < 2; ++a)
#pragma unroll
            for (int b = 0; b < 2; ++b)
#pragma unroll
                for (int m = 0; m < 4; ++m)
#pragma unroll
                    for (int n = 0; n < 2; ++n) acc[a][b][m][n] = (f32x4){0.f, 0.f, 0.f, 0.f};
        pm = npm; pn = npn; cA = nA; cB = nB; L += G;
    }
    WAIT_V(0);
    if (wr == 0) BAR;
    BAR;
#undef SA
#undef SB
#undef STAGE
#undef LDA
#undef LDB
#undef MMA
}

typedef f32x4 AccT[2][2][4][2];

struct EpiProj {
    bf16_t* P;
    __device__ __forceinline__ void operator()(const AccT& acc, int pm, int pn, int wr, int wc, int fr, int fq) const {
#pragma unroll
        for (int ai = 0; ai < 2; ++ai)
#pragma unroll
            for (int m = 0; m < 4; ++m) {
                const int row = pm * 256 + ai * 128 + wr * 64 + m * 16 + fr;
#pragma unroll
                for (int bj = 0; bj < 2; ++bj) {
                    const int col = pn * 256 + bj * 128 + wc * 32 + fq * 8;
                    const f32x4 v0 = acc[ai][bj][m][0], v1 = acc[ai][bj][m][1];
                    *(u32x4*)(P + (size_t)row * NPROJ + col) = (u32x4){pk2(v0[0], v0[1]), pk2(v0[2], v0[3]), pk2(v1[0], v1[1]), pk2(v1[2], v1[3])};
                }
            }
    }
};

struct EpiResX {
    struct { const float* xp; const float* xs; float* out; } p;
    __device__ __forceinline__ void operator()(const AccT& acc, int pm, int pn, int wr, int wc, int fr, int fq) const {
#pragma unroll
        for (int ai = 0; ai < 2; ++ai)
#pragma unroll
            for (int m = 0; m < 4; ++m) {
                const int row = pm * 256 + ai * 128 + wr * 64 + m * 16 + fr;
                const float* xr = row < TP ? p.xp + (size_t)row * DM : p.xs + (size_t)(row - TP) * DM;
#pragma unroll
                for (int bj = 0; bj < 2; ++bj)
#pragma unroll
                    for (int n = 0; n < 2; ++n) {
                        const int col = pn * 256 + bj * 128 + wc * 32 + fq * 8 + n * 4;
                        const f32x4 xv = *(const f32x4*)(xr + col);
                        *(f32x4*)(p.out + (size_t)row * DM + col) = xv + acc[ai][bj][m][n];
                    }
            }
    }
};

struct EpiAcc {
    float* out;
    __device__ __forceinline__ void operator()(const AccT& acc, int pm, int pn, int wr, int wc, int fr, int fq) const {
#pragma unroll
        for (int ai = 0; ai < 2; ++ai)
#pragma unroll
            for (int m = 0; m < 4; ++m) {
                const int row = pm * 256 + ai * 128 + wr * 64 + m * 16 + fr;
#pragma unroll
                for (int bj = 0; bj < 2; ++bj)
#pragma unroll
                    for (int n = 0; n < 2; ++n) {
                        const int col = pn * 256 + bj * 128 + wc * 32 + fq * 8 + n * 4;
                        float* o = out + (size_t)row * DM + col;
                        *(f32x4*)o = *(const f32x4*)o + acc[ai][bj][m][n];
                    }
            }
    }
};

struct EpiEraw {
    bf16_t* E; float* ssq;
    __device__ __forceinline__ void operator()(const AccT& acc, int pm, int pn, int wr, int wc, int fr, int fq) const {
#pragma unroll
        for (int ai = 0; ai < 2; ++ai)
#pragma unroll
            for (int m = 0; m < 4; ++m) {
                const int row = pm * 256 + ai * 128 + wr * 64 + m * 16 + fr;
                float s = 0.f;
#pragma unroll
                for (int bj = 0; bj < 2; ++bj) {
                    const int col = pn * 256 + bj * 128 + wc * 32 + fq * 8;
                    const f32x4 v0 = acc[ai][bj][m][0], v1 = acc[ai][bj][m][1];
                    s += v0[0] * v0[0] + v0[1] * v0[1] + v0[2] * v0[2] + v0[3] * v0[3] + v1[0] * v1[0] + v1[1] * v1[1] + v1[2] * v1[2] + v1[3] * v1[3];
                    *(u32x4*)(E + (size_t)row * DM + col) = (u32x4){pk2(v0[0], v0[1]), pk2(v0[2], v0[3]), pk2(v1[0], v1[1]), pk2(v1[2], v1[3])};
                }
                s += __shfl_xor(s, 16); s += __shfl_xor(s, 32);
                if (fq == 0) ssq[(size_t)row * 16 + pn * 4 + wc] = s;
            }
    }
};

struct EpiFinal {
    float* out; const bf16_t* E; const float* ssq; const float* ge;
    __device__ __forceinline__ void operator()(const AccT& acc, int pm, int pn, int wr, int wc, int fr, int fq) const {
#pragma unroll
        for (int ai = 0; ai < 2; ++ai)
#pragma unroll
            for (int m = 0; m < 4; ++m) {
                const int row = pm * 256 + ai * 128 + wr * 64 + m * 16 + fr;
                float s = 0.f;
#pragma unroll
                for (int q = 0; q < 4; ++q) { const f32x4 v = *(const f32x4*)(ssq + (size_t)row * 16 + q * 4); s += v[0] + v[1] + v[2] + v[3]; }
                const float rs = rsqrtf(s * (1.f / DM) + EPS);
#pragma unroll
                for (int bj = 0; bj < 2; ++bj)
#pragma unroll
                    for (int n = 0; n < 2; ++n) {
                        const int col = pn * 256 + bj * 128 + wc * 32 + fq * 8 + n * 4;
                        const u32x2 e = *(const u32x2*)(E + (size_t)row * DM + col);
                        const f32x4 g = *(const f32x4*)(ge + col);
                        const f32x4 a = acc[ai][bj][m][n];
                        f32x4 r;
                        r[0] = sigmoidf_(a[0]) * bflo(e[0]) * rs * g[0];
                        r[1] = sigmoidf_(a[1]) * bfhi(e[0]) * rs * g[1];
                        r[2] = sigmoidf_(a[2]) * bflo(e[1]) * rs * g[2];
                        r[3] = sigmoidf_(a[3]) * bfhi(e[1]) * rs * g[3];
                        float* o = out + (size_t)row * DM + col;
                        *(f32x4*)o = *(const f32x4*)o + r;
                    }
            }
    }
};

struct EpiFfn {
    bf16_t* H; float* ge; float* ue; const float* cw; const float* cb;
    __device__ __forceinline__ void operator()(const AccT& acc, int pm, int pn, int wr, int wc, int fr, int fq) const {
        extern __shared__ __attribute__((aligned(16))) unsigned char smem[];
        float* G = (float*)smem;
#pragma unroll
        for (int ai = 0; ai < 2; ++ai)
#pragma unroll
            for (int m = 0; m < 4; ++m) {
                const int r = ai * 128 + wr * 64 + m * 16 + fr;
#pragma unroll
                for (int n = 0; n < 2; ++n) *(f32x4*)(G + r * 132 + wc * 32 + fq * 8 + n * 4) = acc[ai][0][m][n];
            }
        __syncthreads();
#pragma unroll
        for (int n = 0; n < 2; ++n) {
            const int gc = wc * 32 + fq * 8 + n * 4;
            const int fc = pn * 128 + gc;
            const f32x4 w0 = *(const f32x4*)(cw + fc), w1 = *(const f32x4*)(cw + DFF + fc), w2 = *(const f32x4*)(cw + 2 * DFF + fc), bb = *(const f32x4*)(cb + fc);
#pragma unroll
            for (int ai = 0; ai < 2; ++ai)
#pragma unroll
                for (int m = 0; m < 4; ++m) {
                    const int r = ai * 128 + wr * 64 + m * 16 + fr;
                    const f32x4 gv = acc[ai][0][m][n], uv = acc[ai][1][m][n];
                    if (r == 0 || r == 255) {
                        *(f32x4*)(ge + ((size_t)pm * 4 + (r == 0 ? 0 : 3)) * DFF + fc) = gv;
                        *(f32x4*)(ue + ((size_t)pm * 2 + (r == 0 ? 0 : 1)) * DFF + fc) = uv;
                    } else {
                        if (r == 1) *(f32x4*)(ge + ((size_t)pm * 4 + 1) * DFF + fc) = gv;
                        if (r == 254) *(f32x4*)(ge + ((size_t)pm * 4 + 2) * DFF + fc) = gv;
                        const f32x4 gm = *(const f32x4*)(G + (r - 1) * 132 + gc), gp = *(const f32x4*)(G + (r + 1) * 132 + gc);
                        f32x4 hv;
#pragma unroll
                        for (int j = 0; j < 4; ++j) { const float cv = w0[j] * gm[j] + w1[j] * gv[j] + w2[j] * gp[j] + bb[j]; hv[j] = siluf(cv) * uv[j]; }
                        u32x2 o; o[0] = pk2(hv[0], hv[1]); o[1] = pk2(hv[2], hv[3]);
                        *(u32x2*)(H + (size_t)(pm * 256 + r) * DFF + fc) = o;
                    }
                }
        }
        __syncthreads();
    }
};

template <int CTRL> __device__ __forceinline__ float dppf(float v) { return __int_as_float(__builtin_amdgcn_update_dpp(0, __float_as_int(v), CTRL, 0xF, 0xF, false)); }

struct EpiFfnP {
    bf16_t* H; float* ge; float* ue; const float* cw; const float* cb;
    __device__ __forceinline__ void operator()(const AccT& acc, int pm, int pn, int wr, int wc, int fr, int fq) const {
        extern __shared__ __attribute__((aligned(16))) unsigned char smem[];
        float* halo = (float*)(smem + 131072);
#pragma unroll
        for (int ai = 0; ai < 2; ++ai)
#pragma unroll
            for (int n = 0; n < 2; ++n) {
                if (fr == 0) *(f32x4*)(halo + ((ai * 2 + wr) * 2 + 0) * 128 + wc * 32 + fq * 8 + n * 4) = acc[ai][0][0][n];
                if (fr == 15) *(f32x4*)(halo + ((ai * 2 + wr) * 2 + 1) * 128 + wc * 32 + fq * 8 + n * 4) = acc[ai][0][3][n];
            }
        asm volatile("s_waitcnt lgkmcnt(0)" ::: "memory");
        __builtin_amdgcn_s_barrier();
        __builtin_amdgcn_s_barrier();
        asm volatile("" ::: "memory");
        u32x2 hold[2][4];
#pragma unroll
        for (int n = 0; n < 2; ++n) {
            const int gc = wc * 32 + fq * 8 + n * 4;
            const int fc = pn * 128 + gc;
            const f32x4 w0 = *(const f32x4*)(cw + fc), w1 = *(const f32x4*)(cw + DFF + fc), w2 = *(const f32x4*)(cw + 2 * DFF + fc), bb = *(const f32x4*)(cb + fc);
#pragma unroll
            for (int ai = 0; ai < 2; ++ai) {
                f32x4 ha = {0.f, 0.f, 0.f, 0.f}, hb = {0.f, 0.f, 0.f, 0.f};
                if (wr == 1) ha = *(const f32x4*)(halo + ((ai * 2 + 0) * 2 + 1) * 128 + gc);
                else if (ai == 1) ha = *(const f32x4*)(halo + ((0 * 2 + 1) * 2 + 1) * 128 + gc);
                if (wr == 0) hb = *(const f32x4*)(halo + ((ai * 2 + 1) * 2 + 0) * 128 + gc);
                else if (ai == 0) hb = *(const f32x4*)(halo + ((1 * 2 + 0) * 2 + 0) * 128 + gc);
#pragma unroll
                for (int m = 0; m < 4; ++m) {
                    const int r = ai * 128 + wr * 64 + m * 16 + fr;
                    const f32x4 gv = acc[ai][0][m][n], uv = acc[ai][1][m][n];
                    f32x4 gm, gp;
#pragma unroll
                    for (int j = 0; j < 4; ++j) {
                        if (m > 0) { const float t = (fr == 15) ? acc[ai][0][m > 0 ? m - 1 : 0][n][j] : gv[j]; gm[j] = dppf<0x121>(t); }
                        else { gm[j] = dppf<0x121>(gv[j]); if (fr == 0) gm[j] = ha[j]; }
                        if (m < 3) { const float t = (fr == 0) ? acc[ai][0][m < 3 ? m + 1 : 3][n][j] : gv[j]; gp[j] = dppf<0x12F>(t); }
                        else { gp[j] = dppf<0x12F>(gv[j]); if (fr == 15) gp[j] = hb[j]; }
                    }
                    if (r == 0 || r == 255) {
                        *(f32x4*)(ge + ((size_t)pm * 4 + (r == 0 ? 0 : 3)) * DFF + fc) = gv;
                        *(f32x4*)(ue + ((size_t)pm * 2 + (r == 0 ? 0 : 1)) * DFF + fc) = uv;
                    } else {
                        if (r == 1) *(f32x4*)(ge + ((size_t)pm * 4 + 1) * DFF + fc) = gv;
                        if (r == 254) *(f32x4*)(ge + ((size_t)pm * 4 + 2) * DFF + fc) = gv;
                        f32x4 hv;
#pragma unroll
                        for (int j = 0; j < 4; ++j) { const float cv = w0[j] * gm[j] + w1[j] * gv[j] + w2[j] * gp[j] + bb[j]; hv[j] = siluf(cv) * uv[j]; }
                        u32x2 o; o[0] = pk2(hv[0], hv[1]); o[1] = pk2(hv[2], hv[3]);
                        if (n == 0) hold[ai][m] = o;
                        else *(u32x4*)(H + (((size_t)pm * (DFF / 64) + (fc >> 6)) * 256 + r) * 64 + ((fc - 4) & 63)) = (u32x4){hold[ai][m][0], hold[ai][m][1], o[0], o[1]};
                    }
                }
            }
        }
    }
};

__device__ void ffn_edges(const Params& p) {
    bf16_t* H = (bf16_t*)(p.ws + OFF_PROJ);
    const float* ge = (const float*)(p.ws + OFF_GE);
    const float* ue = (const float*)(p.ws + OFF_UE);
    const int total = 320 * 2 * DFF;
    for (int idx = blockIdx.x * NTHR + threadIdx.x; idx < total; idx += gridDim.x * NTHR) {
        const int c = idx % DFF, e = (idx / DFF) & 1, pm = idx / (2 * DFF);
        const int tok = pm * 256 + (e ? 255 : 0);
        int s0, S; tok_seq(tok, s0, S);
        float gm, g0, gp, up;
        if (e == 0) {
            gm = (tok == s0) ? 0.f : ge[((size_t)(pm - 1) * 4 + 3) * DFF + c];
            g0 = ge[((size_t)pm * 4 + 0) * DFF + c]; gp = ge[((size_t)pm * 4 + 1) * DFF + c]; up = ue[((size_t)pm * 2 + 0) * DFF + c];
        } else {
            gm = ge[((size_t)pm * 4 + 2) * DFF + c]; g0 = ge[((size_t)pm * 4 + 3) * DFF + c];
            gp = (tok == s0 + S - 1) ? 0.f : ge[((size_t)(pm + 1) * 4 + 0) * DFF + c]; up = ue[((size_t)pm * 2 + 1) * DFF + c];
        }
        const float cv = p.ffn_conv_w[c] * gm + p.ffn_conv_w[DFF + c] * g0 + p.ffn_conv_w[2 * DFF + c] * gp + p.ffn_conv_b[c];
        H[(((size_t)(tok >> 8) * (DFF / 64) + (c >> 6)) * 256 + (tok & 255)) * 64 + (c & 63)] = f2bf(siluf(cv) * up);
    }
}

__device__ __forceinline__ void qk_norm_rope(const Params& p, int chunk, int h, int t6, int nthr) {
    bf16_t* proj = (bf16_t*)(p.ws + OFF_PROJ);
    bf16_t* kp = (bf16_t*)(p.ws + OFF_HN) + (size_t)T * 512;
    const int tk0 = chunk * 64;
    int s0, S; tok_seq(tk0, s0, S);
    const double INVF[8] = {0.15915494309189535, 0.03086376340470123, 0.005985185712713705, 0.001160663641240061,
                            0.00022507907903927653, 4.364795279280289e-05, 8.464330808241401e-06, 1.6414262627950345e-06};
    constexpr int NIT = 6;
    u32x4 rawv[NIT];
    const float gsub0 = 0.f; (void)gsub0;
#pragma unroll
    for (int it = 0; it < NIT; ++it) {
        const int item = t6 + it * nthr;
        if (item < 2048) {
            const int v = item >> 3, sub = item & 7, tokl = v >> 2, which = (v >> 1) & 1, c = v & 1;
            rawv[it] = *(const u32x4*)(proj + (size_t)(tk0 + tokl) * NPROJ + 2048 + which * 512 + h * 128 + c * 64 + sub * 8);
        }
    }
#pragma unroll
    for (int it = 0; it < NIT; ++it) {
        const int item = t6 + it * nthr;
        if (item < 2048) {
            const int v = item >> 3, sub = item & 7;
            const int tokl = v >> 2, which = (v >> 1) & 1, c = v & 1;
            const int tok = tk0 + tokl;
            bf16_t* ptr = proj + (size_t)tok * NPROJ + 2048 + which * 512 + h * 128 + c * 64 + sub * 8;
            const u32x4 raw = rawv[it];
            float f[8];
#pragma unroll
            for (int e = 0; e < 4; ++e) { f[2 * e] = bflo(raw[e]); f[2 * e + 1] = bfhi(raw[e]); }
            float ss = 0.f;
#pragma unroll
            for (int e = 0; e < 8; ++e) ss += f[e] * f[e];
            ss += __shfl_xor(ss, 1); ss += __shfl_xor(ss, 2); ss += __shfl_xor(ss, 4);
            const float rs = rsqrtf(ss * (1.f / 64.f) + EPS);
            float y[8], pr[8];
#pragma unroll
            for (int e = 0; e < 8; ++e) y[e] = f[e] * rs * p.da_qk_norm_g[which * 64 + sub * 8 + e];
#pragma unroll
            for (int e = 0; e < 8; ++e) pr[e] = __shfl_xor(y[e], 1);
            if (sub < 2) {
                const int pos = tok - s0;
#pragma unroll
                for (int e = 0; e < 8; ++e) {
                    const double rr = (double)pos * INVF[e];
                    const float fr_ = (float)(rr - floor(rr));
                    const float sn = __builtin_amdgcn_sinf(fr_), cs = __builtin_amdgcn_cosf(fr_);
                    y[e] = (sub == 0) ? (y[e] * cs - pr[e] * sn) : (y[e] * cs + pr[e] * sn);
                }
            }
            if (which == 0) {
#pragma unroll
                for (int e = 0; e < 8; ++e) y[e] *= 0.18033688011112042f;
            }
            const u32x4 yo = {pk2(y[0], y[1]), pk2(y[2], y[3]), pk2(y[4], y[5]), pk2(y[6], y[7])};
            if (which == 0) *(u32x4*)ptr = yo;
            else *(u32x4*)(kp + ((size_t)chunk * 4 + h) * 8192 + c * 4096 + tokl * 64 + sub * 8) = yo;
        }
    }
}

__device__ void dn_prep_unit(const Params& p, int chunk, int h) {
    extern __shared__ __attribute__((aligned(16))) unsigned char smem[];
    bf16_t* Kb = (bf16_t*)smem;
    float* Kf = (float*)(smem + 17408);
    float* Vf = (float*)(smem + 50176);
    float* KK = (float*)(smem + 82944);
    float* Am = (float*)(smem + 99584);
    float* gs = (float*)(smem + 132352);
    float* bs = gs + 128;
    float* gcs = bs + 128;
    float* es = gcs + 128;
    int tid_ = threadIdx.x; asm volatile("" : "+v"(tid_));
    const int tid = tid_, lane = tid & 63, wave = tid >> 6, fr = lane & 15, fq = lane >> 4;
    const bf16_t* proj = (const bf16_t*)(p.ws + OFF_PROJ);
    bf16_t* qn = (bf16_t*)(p.ws + OFF_QN);
    bf16_t* kn = (bf16_t*)(p.ws + OFF_KN);
    bf16_t* knt = (bf16_t*)(p.ws + OFF_KNT);
    const float* dab = (const float*)(p.ws + OFF_DAB);
    float* gcg = (float*)(p.ws + OFF_GC);
    bf16_t* ut = (bf16_t*)p.out;
    bf16_t* wrr = (bf16_t*)p.out + (size_t)10240 * 8192;
    const int tk0 = chunk * 64;
    int s0, S; tok_seq(tk0, s0, S);
    bf16_t* VsA = (bf16_t*)(smem + 99584);
#pragma unroll
    for (int it = 0; it < 2; ++it) {
        const int pi = tid + NTHR * it, row = pi >> 4, sub = pi & 15;
        const u32x4 raw = *(const u32x4*)(proj + (size_t)(tk0 + row) * NPROJ + 3072 + h * 128 + sub * 8);
        unsigned* dd = (unsigned*)(VsA + row * 130 + sub * 8);
        dd[0] = raw[0]; dd[1] = raw[1]; dd[2] = raw[2]; dd[3] = raw[3];
    }
    {
        const int rbase = tk0 + wave * 8;
#pragma unroll
        for (int mat = 0; mat < 3; ++mat) {
            const int colb = mat * 512 + h * 128 + 2 * lane;
            unsigned raw[12];
#pragma unroll
            for (int i = 0; i < 12; ++i) { const int t = rbase - 2 + i; raw[i] = (t >= s0 && t < s0 + S) ? *(const unsigned*)(proj + (size_t)t * NPROJ + colb) : 0u; }
            float cw0[5], cw1[5];
#pragma unroll
            for (int j = 0; j < 5; ++j) { cw0[j] = p.dn_conv_w[j * 1536 + colb]; cw1[j] = p.dn_conv_w[j * 1536 + colb + 1]; }
#pragma unroll
            for (int rr = 0; rr < 8; ++rr) {
                float o0 = 0.f, o1 = 0.f;
#pragma unroll
                for (int j = 0; j < 5; ++j) { o0 += cw0[j] * bflo(raw[rr + j]); o1 += cw1[j] * bfhi(raw[rr + j]); }
                o0 = siluf(o0); o1 = siluf(o1);
                const int row = wave * 8 + rr;
                if (mat < 2) {
                    float ss = wave_sum(o0 * o0 + o1 * o1);
                    float sc = rsqrtf(ss + EPS);
                    if (mat == 0) sc *= 0.08838834764831845f;
                    o0 *= sc; o1 *= sc;
                    const unsigned pk = pk2(o0, o1);
                    if (mat == 0) *(unsigned*)(qn + (size_t)(tk0 + row) * 512 + h * 128 + 2 * lane) = pk;
                    else {
                        *(unsigned*)(kn + (size_t)(tk0 + row) * 512 + h * 128 + 2 * lane) = pk;
                        *(unsigned*)(Kb + row * 136 + 2 * lane) = pk;
                        Kf[row * 128 + 2 * lane] = o0; Kf[row * 128 + 2 * lane + 1] = o1;
                    }
                } else { Vf[row * 128 + 2 * lane] = o0; Vf[row * 128 + 2 * lane + 1] = o1; }
            }
        }
        if (lane < 16) {
            const int rr = lane & 7, d = lane >> 3, row = wave * 8 + rr, t = tk0 + row;
            const float da = dab[(size_t)t * 16 + d * 4 + h], db = dab[(size_t)t * 16 + 8 + d * 4 + h];
            const float xx = da + p.dn_dt_bias[d * 4 + h];
            const float sp = fmaxf(xx, 0.f) + log1pf(__expf(-fabsf(xx)));
            gs[d * 64 + row] = -__expf(p.dn_a_log[d * 4 + h]) * sp;
            bs[d * 64 + row] = sigmoidf_(db);
        }
    }
    __syncthreads();
    if (wave < 2) {
        const int d = wave;
        float v = gs[d * 64 + lane];
#pragma unroll
        for (int off = 1; off < 64; off <<= 1) {
            const float tu = __shfl_up(v, off), td = __shfl_down(v, off);
            if (d == 0) { if (lane >= off) v += tu; } else { if (lane + off < 64) v += td; }
        }
        gcs[d * 64 + lane] = v;
        gcg[(size_t)(d * 4 + h) * T + tk0 + lane] = v;
    }
    {
        const int rt = wave & 3, ct0 = (wave >> 2) * 2;
#pragma unroll
        for (int cc = 0; cc < 2; ++cc) {
            const int ct = ct0 + cc;
            f32x4 a4 = {0.f, 0.f, 0.f, 0.f};
#pragma unroll
            for (int ks = 0; ks < 4; ++ks) {
                const bf16x8 a = *(const bf16x8*)(Kb + (rt * 16 + fr) * 136 + ks * 32 + fq * 8);
                const bf16x8 b = *(const bf16x8*)(Kb + (ct * 16 + fr) * 136 + ks * 32 + fq * 8);
                a4 = MFMA16(a, b, a4);
            }
#pragma unroll
            for (int j = 0; j < 4; ++j) KK[(rt * 16 + fq * 4 + j) * 65 + ct * 16 + fr] = a4[j];
        }
    }
    {
        bf16_t* vp = (bf16_t*)(p.ws + OFF_HN);
#pragma unroll
        for (int it = 0; it < 2; ++it) {
            const int item = tid + NTHR * it, dv = item >> 3, piece = item & 7;
            unsigned o[4];
#pragma unroll
            for (int e = 0; e < 4; ++e) { const unsigned lo = VsA[(piece * 8 + 2 * e) * 130 + dv], hi = VsA[(piece * 8 + 2 * e + 1) * 130 + dv]; o[e] = lo | (hi << 16); }
            *(u32x4*)(vp + ((size_t)chunk * 4 + h) * 8192 + dv * 64 + piece * 8) = (u32x4){o[0], o[1], o[2], o[3]};
        }
    }
    {
        const int dk = tid >> 2, piece = tid & 3;
        unsigned o[8];
#pragma unroll
        for (int e = 0; e < 8; ++e) o[e] = pk2(Kf[(piece * 16 + 2 * e) * 128 + dk], Kf[(piece * 16 + 2 * e + 1) * 128 + dk]);
        bf16_t* dst = knt + ((size_t)chunk * 4 + h) * 8192 + dk * 64 + piece * 16;
        *(u32x4*)dst = (u32x4){o[0], o[1], o[2], o[3]};
        *(u32x4*)(dst + 8) = (u32x4){o[4], o[5], o[6], o[7]};
    }
    __syncthreads();
    if (tid < 128) es[tid] = bs[tid] * __expf(gcs[tid]);
    for (int idx = tid; idx < 8192; idx += NTHR) {
        const int d = idx >> 12, ip = (idx >> 6) & 63, jp = idx & 63;
        const int ri = d ? 63 - ip : ip, rj = d ? 63 - jp : jp;
        float val = 0.f;
        if (jp < ip) val = bs[d * 64 + ri] * KK[ri * 65 + rj] * __expf(gcs[d * 64 + ri] - gcs[d * 64 + rj]);
        Am[idx] = val;
    }
    __syncthreads();
#ifndef NO_S5
    bf16_t* Tb0 = (bf16_t*)smem;
    bf16_t* Tb1 = (bf16_t*)(smem + 82944);
    if (__builtin_amdgcn_readfirstlane(wave) < 2) {
        const int d = __builtin_amdgcn_readfirstlane(wave), cp = lane;
        float x[64];
#pragma unroll
        for (int ip = 0; ip < 64; ++ip) x[ip] = (ip == cp) ? 1.f : 0.f;
        const float* Ad = Am + d * 4096;
        asm volatile("" : "+v"(Ad));
        f32x4 cur[4], nxt[4], dg[3];
#pragma unroll
        for (int k = 0; k < 3; ++k) dg[k] = *(const f32x4*)(Ad + (k + 1) * 64);
#pragma unroll
        for (int k = 0; k < 4; ++k) cur[k] = *(const f32x4*)(Ad + (4 + k) * 64);
#pragma unroll
        for (int b = 0; b < 16; ++b) {
            float t0 = 0.f, t1 = 0.f, t2 = 0.f, t3 = 0.f;
            f32x4 dn[3];
#pragma unroll
            for (int q = 0; q < b; ++q) {
                if (q + 1 < b) {
#pragma unroll
                    for (int k = 0; k < 4; ++k) nxt[k] = *(const f32x4*)(Ad + (4 * b + k) * 64 + (q + 1) * 4);
                } else {
#pragma unroll
                    for (int k = 0; k < 3; ++k) dg[k] = *(const f32x4*)(Ad + (4 * b + k + 1) * 64 + b * 4);
                    if (b < 15) {
#pragma unroll
                        for (int k = 0; k < 4; ++k) nxt[k] = *(const f32x4*)(Ad + (4 * (b + 1) + k) * 64);
                    }
                }
                t0 += cur[0][0] * x[4 * q] + cur[0][1] * x[4 * q + 1] + cur[0][2] * x[4 * q + 2] + cur[0][3] * x[4 * q + 3];
                t1 += cur[1][0] * x[4 * q] + cur[1][1] * x[4 * q + 1] + cur[1][2] * x[4 * q + 2] + cur[1][3] * x[4 * q + 3];
                t2 += cur[2][0] * x[4 * q] + cur[2][1] * x[4 * q + 1] + cur[2][2] * x[4 * q + 2] + cur[2][3] * x[4 * q + 3];
                t3 += cur[3][0] * x[4 * q] + cur[3][1] * x[4 * q + 1] + cur[3][2] * x[4 * q + 2] + cur[3][3] * x[4 * q + 3];
                asm volatile("" ::: "memory");
#pragma unroll
                for (int k = 0; k < 4; ++k) cur[k] = nxt[k];
            }
            (void)dn;
            x[4 * b] -= t0;
            x[4 * b + 1] -= t1 + dg[0][0] * x[4 * b];
            x[4 * b + 2] -= t2 + dg[1][0] * x[4 * b] + dg[1][1] * x[4 * b + 1];
            x[4 * b + 3] -= t3 + dg[2][0] * x[4 * b] + dg[2][1] * x[4 * b + 1] + dg[2][2] * x[4 * b + 2];
            asm volatile("" ::: "memory");
        }
        if (d == 0) {
#pragma unroll
            for (int ip = 0; ip < 64; ++ip) Tb0[ip * 72 + cp] = f2bf(x[ip]);
        } else {
#pragma unroll
            for (int ip = 0; ip < 64; ++ip) Tb1[(63 - ip) * 72 + (63 - cp)] = f2bf(x[ip]);
        }
    } else {
        qk_norm_rope(p, chunk, h, tid - 128, NTHR - 128);
    }
    __syncthreads();
    {
        const int d = __builtin_amdgcn_readfirstlane(wave >> 2), mat = __builtin_amdgcn_readfirstlane((wave >> 1) & 1), half = wave & 1;
        const bf16_t* Tb = d ? Tb1 : Tb0;
        const float* R = (mat ? Kf : Vf) + fq * 8 * 128 + half * 64 + fr;
        const float* sc = (mat ? es : bs) + d * 64 + fq * 8;
        asm volatile("" : "+v"(R), "+v"(sc));
        f32x4 acc[4][4];
#pragma unroll
        for (int c4 = 0; c4 < 4; ++c4)
#pragma unroll
            for (int rt = 0; rt < 4; ++rt) acc[c4][rt] = (f32x4){0.f, 0.f, 0.f, 0.f};
#pragma unroll
        for (int ks = 0; ks < 2; ++ks) {
            bf16x8 tf[4];
#pragma unroll
            for (int rt = 0; rt < 4; ++rt) tf[rt] = *(const bf16x8*)(Tb + (rt * 16 + fr) * 72 + ks * 32 + fq * 8);
            const f32x4 s0 = *(const f32x4*)(sc + ks * 32), s1 = *(const f32x4*)(sc + ks * 32 + 4);
#pragma unroll
            for (int c4 = 0; c4 < 4; ++c4) {
                const float* rp = R + ks * 32 * 128 + c4 * 16;
                u32x4 w;
                w[0] = pk2(rp[0] * s0[0], rp[128] * s0[1]); w[1] = pk2(rp[256] * s0[2], rp[384] * s0[3]);
                w[2] = pk2(rp[512] * s1[0], rp[640] * s1[1]); w[3] = pk2(rp[768] * s1[2], rp[896] * s1[3]);
                const bf16x8 rf = __builtin_bit_cast(bf16x8, w);
                if (mat == 0) {
#pragma unroll
                    for (int rt = 0; rt < 4; ++rt) acc[c4][rt] = MFMA16(tf[rt], rf, acc[c4][rt]);
                } else {
#pragma unroll
                    for (int rt = 0; rt < 4; ++rt) acc[c4][rt] = MFMA16(rf, tf[rt], acc[c4][rt]);
                }
                asm volatile("" ::: "memory");
            }
        }
        const size_t uid = ((size_t)d * NCHUNK + chunk) * 4 + h;
        if (mat == 0) {
#pragma unroll
            for (int c4 = 0; c4 < 4; ++c4)
#pragma unroll
                for (int rt = 0; rt < 4; ++rt) {
                    const f32x4 v = acc[c4][rt];
                    u32x2 o; o[0] = pk2(v[0], v[1]); o[1] = pk2(v[2], v[3]);
                    *(u32x2*)(ut + uid * 8192 + (size_t)((half * 4 + c4) * 16 + fr) * 64 + rt * 16 + fq * 4) = o;
                }
        } else {
#pragma unroll
            for (int c4 = 0; c4 < 4; ++c4)
#pragma unroll
                for (int rt = 0; rt < 4; ++rt) {
                    const f32x4 v = acc[c4][rt];
                    u32x2 o; o[0] = pk2(v[0], v[1]); o[1] = pk2(v[2], v[3]);
                    *(u32x2*)(wrr + uid * 8192 + (size_t)(rt * 16 + fr) * 128 + (half * 4 + c4) * 16 + fq * 4) = o;
                }
        }
    }
#endif
    __syncthreads();
}

__device__ void attn_prep_unit(const Params& p, int chunk, int h) {
    extern __shared__ __attribute__((aligned(16))) unsigned char smem[];
    bf16_t* Vs = (bf16_t*)smem;
    const int tid = threadIdx.x;
    bf16_t* proj = (bf16_t*)(p.ws + OFF_PROJ);
    bf16_t* vp = (bf16_t*)(p.ws + OFF_HN);
    bf16_t* kp = (bf16_t*)(p.ws + OFF_HN) + (size_t)T * 512;
    const int tk0 = chunk * 64;
    int s0, S; tok_seq(tk0, s0, S);
    const double INVF[8] = {0.15915494309189535, 0.03086376340470123, 0.005985185712713705, 0.001160663641240061,
                            0.00022507907903927653, 4.364795279280289e-05, 8.464330808241401e-06, 1.6414262627950345e-06};
#pragma unroll
    for (int it = 0; it < 4; ++it) {
        const int item = tid + NTHR * it, v = item >> 3, sub = item & 7;
        const int tokl = v >> 2, which = (v >> 1) & 1, c = v & 1;
        const int tok = tk0 + tokl;
        bf16_t* ptr = proj + (size_t)tok * NPROJ + 2048 + which * 512 + h * 128 + c * 64 + sub * 8;
        const u32x4 raw = *(const u32x4*)ptr;
        float f[8];
#pragma unroll
        for (int e = 0; e < 4; ++e) { f[2 * e] = bflo(raw[e]); f[2 * e + 1] = bfhi(raw[e]); }
        float ss = 0.f;
#pragma unroll
        for (int e = 0; e < 8; ++e) ss += f[e] * f[e];
        ss += __shfl_xor(ss, 1); ss += __shfl_xor(ss, 2); ss += __shfl_xor(ss, 4);
        const float rs = rsqrtf(ss * (1.f / 64.f) + EPS);
        float y[8], pr[8];
#pragma unroll
        for (int e = 0; e < 8; ++e) y[e] = f[e] * rs * p.da_qk_norm_g[which * 64 + sub * 8 + e];
#pragma unroll
        for (int e = 0; e < 8; ++e) pr[e] = __shfl_xor(y[e], 1);
        if (sub < 2) {
            const int pos = tok - s0;
#pragma unroll
            for (int e = 0; e < 8; ++e) {
                const double rr = (double)pos * INVF[e];
                const float fr_ = (float)(rr - floor(rr));
                const float sn = __builtin_amdgcn_sinf(fr_), cs = __builtin_amdgcn_cosf(fr_);
                y[e] = (sub == 0) ? (y[e] * cs - pr[e] * sn) : (y[e] * cs + pr[e] * sn);
            }
        }
        if (which == 0) {
#pragma unroll
            for (int e = 0; e < 8; ++e) y[e] *= 0.18033688011112042f;
        }
        const u32x4 yo = {pk2(y[0], y[1]), pk2(y[2], y[3]), pk2(y[4], y[5]), pk2(y[6], y[7])};
        if (which == 0) *(u32x4*)ptr = yo;
        else *(u32x4*)(kp + ((size_t)chunk * 4 + h) * 8192 + c * 4096 + tokl * 64 + sub * 8) = yo;
    }
#pragma unroll
    for (int it = 0; it < 2; ++it) {
        const int pi = tid + NTHR * it, row = pi >> 4, sub = pi & 15;
        const u32x4 raw = *(const u32x4*)(proj + (size_t)(tk0 + row) * NPROJ + 3072 + h * 128 + sub * 8);
        unsigned* d = (unsigned*)(Vs + row * 130 + sub * 8);
        d[0] = raw[0]; d[1] = raw[1]; d[2] = raw[2]; d[3] = raw[3];
    }
    __syncthreads();
#pragma unroll
    for (int it = 0; it < 2; ++it) {
        const int item = tid + NTHR * it, dv = item >> 3, piece = item & 7;
        unsigned o[4];
#pragma unroll
        for (int e = 0; e < 4; ++e) { const unsigned lo = Vs[(piece * 8 + 2 * e) * 130 + dv], hi = Vs[(piece * 8 + 2 * e + 1) * 130 + dv]; o[e] = lo | (hi << 16); }
        *(u32x4*)(vp + ((size_t)chunk * 4 + h) * 8192 + dv * 64 + piece * 8) = (u32x4){o[0], o[1], o[2], o[3]};
    }
    __syncthreads();
}

__device__ void dn_scan_unit(const Params& p, int u) {
    extern __shared__ __attribute__((aligned(16))) unsigned char smem[];
    bf16_t* Kb = (bf16_t*)smem;
    bf16_t* Vt = (bf16_t*)smem;
    bf16_t* Qb = (bf16_t*)(smem + 18432);
    bf16_t* QDb = (bf16_t*)(smem + 35840);
    bf16_t* KDt = (bf16_t*)(smem + 53248);
    bf16_t* Wb = (bf16_t*)(smem + 71680);
    bf16_t* St = (bf16_t*)(smem + 89088);
    bf16_t* QKm = (bf16_t*)(smem + 123904);
    float* gcs = (float*)(smem + 133120);
    const int tid = threadIdx.x, lane = tid & 63, wave = tid >> 6, fr = lane & 15, fq = lane >> 4;
    int sq, h, d;
    if (u < 128) { sq = 8 + (u >> 3); h = (u >> 1) & 3; d = u & 1; } else { const int u2 = u - 128; sq = u2 >> 3; h = (u2 >> 1) & 3; d = u2 & 1; }
    const int S = sq < 8 ? 2048 : 4096;
    const int s0 = sq < 8 ? sq * 2048 : TP + (sq - 8) * 4096;
    const int N = S / 64;
    const bf16_t* qn = (const bf16_t*)(p.ws + OFF_QN);
    const bf16_t* kn = (const bf16_t*)(p.ws + OFF_KN);
    const bf16_t* knt = (const bf16_t*)(p.ws + OFF_KNT);
    const float* gcg = (const float*)(p.ws + OFF_GC) + (size_t)(d * 4 + h) * T;
    const bf16_t* ut = (const bf16_t*)p.out;
    const bf16_t* wrr = (const bf16_t*)p.out + (size_t)10240 * 8192;
    bf16_t* proj = (bf16_t*)(p.ws + OFF_PROJ);
    f32x4 sacc[8];
#pragma unroll
    for (int i = 0; i < 8; ++i) sacc[i] = (f32x4){0.f, 0.f, 0.f, 0.f};
    for (int i = tid; i < 128 * 136 / 2; i += NTHR) ((unsigned*)St)[i] = 0u;
    __syncthreads();
    const int rt = wave & 3, cg4 = wave >> 2;
    u32x4 pkq[2], pqq[2], pww[2], pkk[2]; f32x4 pg0[2], pg1[2]; float pgr[2], pgcl, pgcs = 0.f; u32x2 puv[4];
#define SCAN_LOAD(NP) do { const int cis_ = d ? N - 1 - (NP) : (NP); const int tk_ = s0 + cis_ * 64; const int cg_ = tk_ >> 6; \
        const size_t uid_ = ((size_t)d * NCHUNK + cg_) * 4 + h; \
        pgcl = gcg[tk_ + (d ? 0 : 63)]; \
        _Pragma("unroll") for (int it = 0; it < 2; ++it) { const int pi = tid + NTHR * it, row = pi >> 4, sub = pi & 15; \
            pkq[it] = *(const u32x4*)(kn + (size_t)(tk_ + row) * 512 + h * 128 + sub * 8); \
            pqq[it] = *(const u32x4*)(qn + (size_t)(tk_ + row) * 512 + h * 128 + sub * 8); \
            pww[it] = *(const u32x4*)(wrr + uid_ * 8192 + row * 128 + sub * 8); \
            pgr[it] = gcg[tk_ + row]; \
            const int dk = pi >> 3, piece = pi & 7; \
            pkk[it] = *(const u32x4*)(knt + ((size_t)cg_ * 4 + h) * 8192 + dk * 64 + piece * 8); \
            pg0[it] = *(const f32x4*)(gcg + tk_ + piece * 8); pg1[it] = *(const f32x4*)(gcg + tk_ + piece * 8 + 4); } \
        if (tid < 64) pgcs = gcg[tk_ + tid]; \
        _Pragma("unroll") for (int c4 = 0; c4 < 4; ++c4) { const int ct = (wave >> 2) * 4 + c4; puv[c4] = *(const u32x2*)(ut + uid_ * 8192 + (size_t)(ct * 16 + fr) * 64 + (wave & 3) * 16 + fq * 4); } \
    } while (0)
    SCAN_LOAD(0);
    for (int np = 0; np < N; ++np) {
        const int cis = d ? N - 1 - np : np;
        const int tk0 = s0 + cis * 64;
        const float gcl = pgcl;
#pragma unroll
        for (int it = 0; it < 2; ++it) {
            const int pi = tid + NTHR * it, row = pi >> 4, sub = pi & 15;
            const float eg = __expf(pgr[it]);
            *(u32x4*)(Kb + row * 136 + sub * 8) = pkq[it];
            *(u32x4*)(Qb + row * 136 + sub * 8) = pqq[it];
            *(u32x4*)(Wb + row * 136 + sub * 8) = pww[it];
            u32x4 qd;
#pragma unroll
            for (int e = 0; e < 4; ++e) qd[e] = pk2(bflo(pqq[it][e]) * eg, bfhi(pqq[it][e]) * eg);
            *(u32x4*)(QDb + row * 136 + sub * 8) = qd;
            const int dk = pi >> 3, piece = pi & 7;
            const u32x4 kk = pkk[it]; const f32x4 g0 = pg0[it], g1 = pg1[it];
            u32x4 o;
            o[0] = pk2(bflo(kk[0]) * __expf(gcl - g0[0]), bfhi(kk[0]) * __expf(gcl - g0[1]));
            o[1] = pk2(bflo(kk[1]) * __expf(gcl - g0[2]), bfhi(kk[1]) * __expf(gcl - g0[3]));
            o[2] = pk2(bflo(kk[2]) * __expf(gcl - g1[0]), bfhi(kk[2]) * __expf(gcl - g1[1]));
            o[3] = pk2(bflo(kk[3]) * __expf(gcl - g1[2]), bfhi(kk[3]) * __expf(gcl - g1[3]));
            *(u32x4*)(KDt + dk * 72 + piece * 8) = o;
        }
        if (tid < 64) gcs[tid] = pgcs;
        u32x2 uv[4];
#pragma unroll
        for (int c4 = 0; c4 < 4; ++c4) uv[c4] = puv[c4];
        __syncthreads();
        if (np + 1 < N) SCAN_LOAD(np + 1);
#pragma unroll
        for (int cc = 0; cc < 2; ++cc) {
            const int ct = cg4 * 2 + cc;
            f32x4 a4 = {0.f, 0.f, 0.f, 0.f};
#pragma unroll
            for (int ks = 0; ks < 4; ++ks) {
                const bf16x8 a = *(const bf16x8*)(Qb + (rt * 16 + fr) * 136 + ks * 32 + fq * 8);
                const bf16x8 b = *(const bf16x8*)(Kb + (ct * 16 + fr) * 136 + ks * 32 + fq * 8);
                a4 = MFMA16(a, b, a4);
            }
            const int jj = ct * 16 + fr;
            const float gj = gcs[jj];
#pragma unroll
            for (int j = 0; j < 4; ++j) {
                const int i = rt * 16 + fq * 4 + j;
                const bool keep = d ? (jj >= i) : (jj <= i);
                const float val = keep ? a4[j] * __expf(gcs[i] - gj) : 0.f;
                QKm[i * 72 + jj] = f2bf(val);
            }
        }
        f32x4 ws4[4], qs4[4];
#pragma unroll
        for (int c4 = 0; c4 < 4; ++c4) { ws4[c4] = (f32x4){0.f, 0.f, 0.f, 0.f}; qs4[c4] = (f32x4){0.f, 0.f, 0.f, 0.f}; }
#pragma unroll
        for (int ks = 0; ks < 4; ++ks) {
            const bf16x8 aw = *(const bf16x8*)(Wb + (rt * 16 + fr) * 136 + ks * 32 + fq * 8);
            const bf16x8 aq = *(const bf16x8*)(QDb + (rt * 16 + fr) * 136 + ks * 32 + fq * 8);
#pragma unroll
            for (int c4 = 0; c4 < 4; ++c4) {
                const int ct = cg4 * 4 + c4;
                const bf16x8 b = *(const bf16x8*)(St + (ct * 16 + fr) * 136 + ks * 32 + fq * 8);
                ws4[c4] = MFMA16(aw, b, ws4[c4]);
                qs4[c4] = MFMA16(b, aq, qs4[c4]);
            }
        }
        __syncthreads();
#pragma unroll
        for (int c4 = 0; c4 < 4; ++c4) {
            const int ct = cg4 * 4 + c4;
            const float v0 = bflo(uv[c4][0]) - ws4[c4][0], v1 = bfhi(uv[c4][0]) - ws4[c4][1], v2 = bflo(uv[c4][1]) - ws4[c4][2], v3 = bfhi(uv[c4][1]) - ws4[c4][3];
            u32x2 o; o[0] = pk2(v0, v1); o[1] = pk2(v2, v3);
            *(u32x2*)(Vt + (ct * 16 + fr) * 72 + rt * 16 + fq * 4) = o;
        }
        __syncthreads();
#pragma unroll
        for (int ks = 0; ks < 2; ++ks) {
            const bf16x8 a = *(const bf16x8*)(QKm + (rt * 16 + fr) * 72 + ks * 32 + fq * 8);
#pragma unroll
            for (int c4 = 0; c4 < 4; ++c4) {
                const int ct = cg4 * 4 + c4;
                const bf16x8 b = *(const bf16x8*)(Vt + (ct * 16 + fr) * 72 + ks * 32 + fq * 8);
                qs4[c4] = MFMA16(b, a, qs4[c4]);
            }
        }
#pragma unroll
        for (int c4 = 0; c4 < 4; ++c4) {
            const int ct = cg4 * 4 + c4;
            { u32x2 o; o[0] = pk2(qs4[c4][0], qs4[c4][1]); o[1] = pk2(qs4[c4][2], qs4[c4][3]);
              *(u32x2*)(proj + (size_t)(tk0 + rt * 16 + fr) * NPROJ + d * 512 + h * 128 + ct * 16 + fq * 4) = o; }
        }
        const float gl = __expf(gcl);
#pragma unroll
        for (int c8 = 0; c8 < 8; ++c8) sacc[c8] = sacc[c8] * gl;
#pragma unroll
        for (int ks = 0; ks < 2; ++ks) {
            const bf16x8 a = *(const bf16x8*)(KDt + (wave * 16 + fr) * 72 + ks * 32 + fq * 8);
#pragma unroll
            for (int c8 = 0; c8 < 8; ++c8) {
                const bf16x8 b = *(const bf16x8*)(Vt + (c8 * 16 + fr) * 72 + ks * 32 + fq * 8);
                sacc[c8] = MFMA16(a, b, sacc[c8]);
            }
        }
#pragma unroll
        for (int c8 = 0; c8 < 8; ++c8) {
            u32x2 o; o[0] = pk2(sacc[c8][0], sacc[c8][1]); o[1] = pk2(sacc[c8][2], sacc[c8][3]);
            *(u32x2*)(St + (c8 * 16 + fr) * 136 + wave * 16 + fq * 4) = o;
        }
        __syncthreads();
    }
}

template <int ORD>
__device__ __forceinline__ void attn_unit(const Params& p, int a, float lam, float negC) {
    extern __shared__ __attribute__((aligned(16))) unsigned char smem[];
    int tid_ = threadIdx.x; asm volatile("" : "+v"(tid_));
    const int tid = tid_, lane = tid & 63, wave = tid >> 6, fr = lane & 15, fq = lane >> 4;
    int sq, h, qb;
    if (a < 2048) { sq = 8 + (a >> 7); const int rem = a & 127; h = rem >> 5; qb = rem & 31; }
    else { const int a2 = a - 2048; sq = a2 >> 6; const int rem = a2 & 63; h = rem >> 4; qb = rem & 15; }
    const int S = sq < 8 ? 2048 : 4096;
    const int s0 = sq < 8 ? sq * 2048 : TP + (sq - 8) * 4096;
    const int q0 = s0 + qb * 128, nt = S / 64;
    const int c = wave >> 2, wq = wave & 3;
    bf16_t* proj = (bf16_t*)(p.ws + OFF_PROJ);
    const bf16_t* vp = (const bf16_t*)(p.ws + OFF_HN) + ((size_t)(s0 >> 6) * 4 + h) * 8192;
    const bf16_t* kp = (const bf16_t*)(p.ws + OFF_HN) + (size_t)T * 512 + ((size_t)(s0 >> 6) * 4 + h) * 8192;
    bf16x8 qf[2][2];
#pragma unroll
    for (int rt = 0; rt < 2; ++rt)
#pragma unroll
        for (int ks = 0; ks < 2; ++ks)
            qf[rt][ks] = *(const bf16x8*)(proj + (size_t)(q0 + wq * 32 + rt * 16 + fr) * NPROJ + 2048 + h * 128 + c * 64 + ks * 32 + fq * 8);
    f32x4 ot[8][2];
#pragma unroll
    for (int dt = 0; dt < 8; ++dt) { ot[dt][0] = (f32x4){0.f, 0.f, 0.f, 0.f}; ot[dt][1] = (f32x4){0.f, 0.f, 0.f, 0.f}; }
    float lrow[2] = {0.f, 0.f};
    u32x4 kreg[2], vreg[2];
    const int kkey_ = tid >> 3;
    const int kperm = (((kkey_ >> 5) * 2 + ((kkey_ >> 2) & 1)) * 16) + ((kkey_ >> 3) & 3) * 4 + (kkey_ & 3);
#define ATT_LOAD(t) do { const bf16_t* kb_ = kp + (size_t)(t) * (4 * 8192); const bf16_t* vb_ = vp + (size_t)(t) * (4 * 8192); \
        kreg[0] = *(const u32x4*)(kb_ + tid * 8); kreg[1] = *(const u32x4*)(kb_ + 4096 + tid * 8); \
        vreg[0] = *(const u32x4*)(vb_ + tid * 8); vreg[1] = *(const u32x4*)(vb_ + 4096 + tid * 8); } while (0)
#define ATT_STORE(buf) do { bf16_t* Ks_ = (bf16_t*)(smem + (buf) * 36864); bf16_t* Vs_ = Ks_ + 9216; _Pragma("unroll") for (int it = 0; it < 2; ++it) { \
        *(u32x4*)(Ks_ + (it * 64 + kperm) * 72 + (tid & 7) * 8) = kreg[it]; \
        *(u32x4*)(Vs_ + ((tid >> 3) + it * 64) * 72 + (tid & 7) * 8) = vreg[it]; } } while (0)
    if (__builtin_amdgcn_readfirstlane(threadIdx.x) >= 256) __builtin_amdgcn_s_setprio(1);
    f32x4 st[4][2];
    bf16x8 pbp[2][2];
    {
        const u32x4 z4 = {0u, 0u, 0u, 0u};
        pbp[0][0] = pbp[0][1] = pbp[1][0] = pbp[1][1] = __builtin_bit_cast(bf16x8, z4);
        ATT_LOAD(0);
        ATT_STORE(0);
        ATT_LOAD(1);
        ATT_STORE(1);
        __syncthreads();
        bf16_t* Vz = (bf16_t*)(smem + 36864) + 9216;
        for (int i = tid; i < 9216 / 8; i += NTHR) *(u32x4*)(Vz + i * 8) = z4;
        const bf16_t* Ks = (const bf16_t*)smem;
#pragma unroll
        for (int kt = 0; kt < 4; ++kt) {
            st[kt][0] = (f32x4){negC, negC, negC, negC}; st[kt][1] = (f32x4){negC, negC, negC, negC};
#pragma unroll
            for (int ks = 0; ks < 2; ++ks) {
                const bf16x8 ka = *(const bf16x8*)(Ks + (c * 64 + kt * 16 + fr) * 72 + ks * 32 + fq * 8);
                st[kt][0] = MFMA16(ka, qf[0][ks], st[kt][0]);
                st[kt][1] = MFMA16(ka, qf[1][ks], st[kt][1]);
            }
        }
        __syncthreads();
    }
    for (int t = 0; t < nt; ++t) {
        { const int tk = (t + 2 < nt) ? t + 2 : nt - 1;
          const bf16_t* kb_ = kp + (size_t)tk * (4 * 8192); const bf16_t* vb_ = vp + (size_t)t * (4 * 8192);
          kreg[0] = *(const u32x4*)(kb_ + tid * 8); kreg[1] = *(const u32x4*)(kb_ + 4096 + tid * 8);
          vreg[0] = *(const u32x4*)(vb_ + tid * 8); vreg[1] = *(const u32x4*)(vb_ + 4096 + tid * 8); }
        const bf16_t* Ks = (const bf16_t*)(smem + ((t + 1) & 1) * 36864);
        const bf16_t* Vs = Ks + 9216;
        u32x4 pbn[2][2];
#pragma unroll
        for (int kt = 0; kt < 4; ++kt) {
            bf16x8 ka[2], va[2][2];
#pragma unroll
            for (int ks = 0; ks < 2; ++ks) ka[ks] = *(const bf16x8*)(Ks + (c * 64 + kt * 16 + fr) * 72 + ks * 32 + fq * 8);
#pragma unroll
            for (int dd = 0; dd < 2; ++dd)
#pragma unroll
                for (int s = 0; s < 2; ++s) {
                    const int dt = kt * 2 + dd;
                    va[dd][s] = *(const bf16x8*)(Vs + (dt * 16 + fr) * 72 + s * 32 + fq * 8);
                }
            if (ORD == 1) {
#pragma unroll
                for (int dd = 0; dd < 2; ++dd) {
                    const int dt = kt * 2 + dd;
#pragma unroll
                    for (int s = 0; s < 2; ++s) {
                        ot[dt][0] = MFMA16(va[dd][s], pbp[0][s], ot[dt][0]);
                        ot[dt][1] = MFMA16(va[dd][s], pbp[1][s], ot[dt][1]);
                    }
                }
                __builtin_amdgcn_sched_barrier(0);
            }
#pragma unroll
            for (int rt = 0; rt < 2; ++rt) {
                float pv[4];
#pragma unroll
                for (int j = 0; j < 4; ++j) pv[j] = __builtin_amdgcn_exp2f(st[kt][rt][j]);
                lrow[rt] += (pv[0] + pv[1]) + (pv[2] + pv[3]);
                pbn[rt][kt >> 1][(kt & 1) * 2] = pk2(pv[0], pv[1]);
                pbn[rt][kt >> 1][(kt & 1) * 2 + 1] = pk2(pv[2], pv[3]);
            }
            st[kt][0] = (f32x4){negC, negC, negC, negC}; st[kt][1] = (f32x4){negC, negC, negC, negC};
#pragma unroll
            for (int ks = 0; ks < 2; ++ks) {
                st[kt][0] = MFMA16(ka[ks], qf[0][ks], st[kt][0]);
                st[kt][1] = MFMA16(ka[ks], qf[1][ks], st[kt][1]);
            }
            if (ORD == 0) {
#pragma unroll
                for (int dd = 0; dd < 2; ++dd) {
                    const int dt = kt * 2 + dd;
#pragma unroll
                    for (int s = 0; s < 2; ++s) {
                        ot[dt][0] = MFMA16(va[dd][s], pbp[0][s], ot[dt][0]);
                        ot[dt][1] = MFMA16(va[dd][s], pbp[1][s], ot[dt][1]);
                    }
                }
            }
            __builtin_amdgcn_sched_barrier(0);
        }
        pbp[0][0] = __builtin_bit_cast(bf16x8, pbn[0][0]); pbp[0][1] = __builtin_bit_cast(bf16x8, pbn[0][1]);
        pbp[1][0] = __builtin_bit_cast(bf16x8, pbn[1][0]); pbp[1][1] = __builtin_bit_cast(bf16x8, pbn[1][1]);
        ATT_STORE(t & 1);
        __syncthreads();
    }
    {
        const bf16_t* Vs = (const bf16_t*)(smem + ((nt - 1) & 1) * 36864) + 9216;
#pragma unroll
        for (int dt = 0; dt < 8; ++dt)
#pragma unroll
            for (int s = 0; s < 2; ++s) {
                const bf16x8 va = *(const bf16x8*)(Vs + (dt * 16 + fr) * 72 + s * 32 + fq * 8);
                ot[dt][0] = MFMA16(va, pbp[0][s], ot[dt][0]);
                ot[dt][1] = MFMA16(va, pbp[1][s], ot[dt][1]);
            }
        __syncthreads();
    }
#undef ATT_LOAD
#undef ATT_STORE
    __builtin_amdgcn_s_setprio(0);
    float inv[2];
#pragma unroll
    for (int rt = 0; rt < 2; ++rt) { float l = lrow[rt]; l += __shfl_xor(l, 16); l += __shfl_xor(l, 32); inv[rt] = 1.f / l; }
    float* Ox = (float*)smem;
    if (c == 1) {
#pragma unroll
        for (int rt = 0; rt < 2; ++rt)
#pragma unroll
            for (int dt = 0; dt < 8; ++dt) *(f32x4*)(Ox + (wq * 32 + rt * 16 + fr) * 132 + dt * 16 + fq * 4) = ot[dt][rt] * inv[rt];
    }
    __syncthreads();
    if (c == 0) {
#pragma unroll
        for (int rt = 0; rt < 2; ++rt) {
            float ss = 0.f;
#pragma unroll
            for (int dt = 0; dt < 8; ++dt) {
                const f32x4 o2 = *(const f32x4*)(Ox + (wq * 32 + rt * 16 + fr) * 132 + dt * 16 + fq * 4);
                ot[dt][rt] = ot[dt][rt] * inv[rt] - lam * o2;
                ss += ot[dt][rt][0] * ot[dt][rt][0] + ot[dt][rt][1] * ot[dt][rt][1] + ot[dt][rt][2] * ot[dt][rt][2] + ot[dt][rt][3] * ot[dt][rt][3];
            }
            ss += __shfl_xor(ss, 16); ss += __shfl_xor(ss, 32);
            const float rs = rsqrtf(ss * (1.f / 128.f) + EPS) * 0.8f;
            const int row = q0 + wq * 32 + rt * 16 + fr;
#pragma unroll
            for (int dt = 0; dt < 8; ++dt) {
                const f32x4 g = *(const f32x4*)(p.da_subln_g + dt * 16 + fq * 4);
                const f32x4 v = ot[dt][rt] * rs * g;
                u32x2 o; o[0] = pk2(v[0], v[1]); o[1] = pk2(v[2], v[3]);
                *(u32x2*)(proj + (size_t)row * NPROJ + 2048 + h * 128 + dt * 16 + fq * 4) = o;
            }
        }
    }
    __syncthreads();
}

__device__ void dn_combine(const Params& p) {
    bf16_t* proj = (bf16_t*)(p.ws + OFF_PROJ);
    const int tid = threadIdx.x, lane = tid & 63, wave = tid >> 6;
    float gn[8];
#pragma unroll
    for (int e = 0; e < 8; ++e) gn[e] = p.dn_norm_g[(lane * 8 + e) & 127];
    for (int t0 = (blockIdx.x * 8 + wave) * 4; t0 < T; t0 += gridDim.x * 8 * 4) {
        u32x4 a[4], b[4], z[4];
#pragma unroll
        for (int k = 0; k < 4; ++k) { const bf16_t* row = proj + (size_t)(t0 + k) * NPROJ; a[k] = *(const u32x4*)(row + lane * 8); b[k] = *(const u32x4*)(row + 512 + lane * 8); z[k] = *(const u32x4*)(row + 1536 + lane * 8); }
#pragma unroll
        for (int k = 0; k < 4; ++k) {
            float s[8], zz[8];
#pragma unroll
            for (int e = 0; e < 4; ++e) { s[2 * e] = bflo(a[k][e]) + bflo(b[k][e]); s[2 * e + 1] = bfhi(a[k][e]) + bfhi(b[k][e]); zz[2 * e] = bflo(z[k][e]); zz[2 * e + 1] = bfhi(z[k][e]); }
            float ss = 0.f;
#pragma unroll
            for (int e = 0; e < 8; ++e) ss += s[e] * s[e];
            ss += __shfl_xor(ss, 1); ss += __shfl_xor(ss, 2); ss += __shfl_xor(ss, 4); ss += __shfl_xor(ss, 8);
            const float rs = rsqrtf(ss * (1.f / 128.f) + EPS);
            float y[8];
#pragma unroll
            for (int e = 0; e < 8; ++e) y[e] = s[e] * rs * gn[e] * siluf(zz[e]);
            *(u32x4*)(proj + (size_t)(t0 + k) * NPROJ + 1536 + lane * 8) = (u32x4){pk2(y[0], y[1]), pk2(y[2], y[3]), pk2(y[4], y[5]), pk2(y[6], y[7])};
        }
    }
}

__device__ void pe_convert(const Params& p) {
    bf16_t* pe = (bf16_t*)(p.ws + OFF_PE);
    const size_t total = (size_t)T * PLE / 4, stride = (size_t)gridDim.x * NTHR;
    for (size_t i0 = (size_t)blockIdx.x * NTHR + threadIdx.x; i0 < total; i0 += 4 * stride) {
        f32x4 v[4];
#pragma unroll
        for (int k = 0; k < 4; ++k) { const size_t i = i0 + k * stride; if (i < total) v[k] = *(const f32x4*)(prow(p, (int)(i >> 6)) + (int)(i & 63) * 4); }
#pragma unroll
        for (int k = 0; k < 4; ++k) { const size_t i = i0 + k * stride; if (i < total) { u32x2 o; o[0] = pk2(v[k][0], v[k][1]); o[1] = pk2(v[k][2], v[k][3]); *(u32x2*)(pe + (i >> 6) * PLE + (i & 63) * 4) = o; } }
    }
}

#ifndef DUMP_MODE
#define DUMP_MODE 6
#endif
__device__ void dump_phase(const Params& p) {
    const bf16_t* proj = (const bf16_t*)(p.ws + OFF_PROJ);
    const bf16_t* hn = (const bf16_t*)(p.ws + OFF_HN);
    const bf16_t* qk = (const bf16_t*)(p.ws + OFF_QK);
    const float* dab = (const float*)(p.ws + OFF_DAB);
    const float* gc = (const float*)(p.ws + OFF_GC);
    const size_t total = (size_t)T * DM;
    for (size_t i = (size_t)blockIdx.x * NTHR + threadIdx.x; i < total; i += (size_t)gridDim.x * NTHR) {
        const size_t t = i >> 10; const int c = (int)(i & 1023);
        float v = 1.f;
        if (DUMP_MODE == 1) v += bf2f(hn[i]) + dab[t * 16 + (c & 15)];
        if (DUMP_MODE == 2 || DUMP_MODE == 3) { v += bf2f(proj[t * NPROJ + c]) + bf2f(proj[t * NPROJ + 1024 + c]) + bf2f(proj[t * NPROJ + 2048 + c]); if (c < 512) v += bf2f(proj[t * NPROJ + 3072 + c]); }
        if (DUMP_MODE == 3) {
            v += bf2f(qk[i]);
            if (c < 512) v += bf2f(qk[total + t * 512 + c]);
            if (c < 512) v += bf2f(hn[t * 512 + c]);
            if (c < 8) v += gc[(size_t)c * T + t];
            const unsigned w = ((const unsigned*)p.out)[i];
            v += bflo(w) + bfhi(w);
        }
        if (DUMP_MODE == 4) { v += 100.f * bf2f(proj[t * NPROJ + c]); }
        if (DUMP_MODE == 5) { v += 100.f * bf2f(qk[i]); if (c < 512) v += 100.f * bf2f(qk[total + t * 512 + c]) + bf2f(hn[t * 512 + c]); if (c < 8) v += gc[(size_t)c * T + t]; v += bf2f(proj[t * NPROJ + 2048 + c]); }
        if (DUMP_MODE == 6) { const unsigned w = ((const unsigned*)p.out)[i]; v += fminf(fmaxf(bflo(w) + bfhi(w), -8.f), 8.f); }
        p.out[i] = v;
    }
}

#define XB_TMO      128
#define XB_XCNT(j)  (256  + 64 * (j))
#define XB_XSUB(j)  (1280 + 64 * (j))
#define XB_XGEN(j)  (2304 + 64 * (j))
#define XB_TOP      3328
#define XB_TOPGEN   3392
#define XCD_BAR_WORDS 3456
#define XB_SPIN_CAP (1u << 18)

__device__ __forceinline__ unsigned xb_ld(unsigned* p)              { return __hip_atomic_load(p, __ATOMIC_RELAXED, __HIP_MEMORY_SCOPE_AGENT); }
__device__ __forceinline__ unsigned xb_add(unsigned* p, unsigned v) { return __hip_atomic_fetch_add(p, v, __ATOMIC_RELAXED, __HIP_MEMORY_SCOPE_AGENT); }
__device__ __forceinline__ unsigned xb_xcc_id() { return (unsigned)__builtin_amdgcn_s_getreg((3 << 11) | 20) & 0xFu; }
#define XB_SPIN(cond, bar) do { unsigned _sp = 0; while (cond) { __builtin_amdgcn_s_sleep(1); \
    if ((++_sp & 255u) == 0u) { if (xb_ld(&(bar)[XB_TMO])) break; if (_sp > XB_SPIN_CAP) { atomicAdd(&(bar)[XB_TMO], 1u); break; } } } } while (0)

struct XcdBarrier {
    unsigned* bar; unsigned x;
    volatile LAS unsigned* st;
};

__device__ __forceinline__ XcdBarrier xcd_barrier_post(unsigned* bar, volatile LAS unsigned* st) {
    XcdBarrier b; b.bar = bar; b.x = xb_xcc_id(); b.st = st;
    if (threadIdx.x == 0) (void)xb_add(&bar[XB_XCNT(b.x)], 1u);
    return b;
}
__device__ __forceinline__ void xcd_barrier_complete(unsigned* bar, unsigned x, unsigned& nloc, unsigned& nx) {
    const unsigned G = gridDim.x * gridDim.y * gridDim.z;
    unsigned sum, cnt, mine, sp = 0u;
    for (;;) {
        sum = 0u; cnt = 0u; mine = 0u;
#pragma unroll
        for (unsigned j = 0; j < 16; ++j) { const unsigned c = xb_ld(&bar[XB_XCNT(j)]); sum += c; cnt += (c > 0u) ? 1u : 0u; mine = (j == x) ? c : mine; }
        if (sum == G) break;
        __builtin_amdgcn_s_sleep(1);
        if ((++sp & 255u) == 0u) { if (xb_ld(&bar[XB_TMO])) break; if (sp > XB_SPIN_CAP) { atomicAdd(&bar[XB_TMO], 1u); break; } }
    }
    nloc = mine > 0u ? mine : 1u; nx = cnt > 0u ? cnt : 1u;
}

__device__ __forceinline__ void xcd_barrier(const XcdBarrier& b) {
    asm volatile("s_waitcnt vmcnt(0)" ::: "memory");
    __syncthreads();
    if (threadIdx.x == 0) {
        unsigned* bar = b.bar;
        __builtin_amdgcn_s_waitcnt(0);
        unsigned nloc = b.st[0], nx = b.st[1];
        if (nloc == 0u) { xcd_barrier_complete(bar, b.x, nloc, nx); b.st[0] = nloc; b.st[1] = nx; }
        const unsigned old = xb_add(&bar[XB_XSUB(b.x)], 1u);
        const unsigned gen = old / nloc;
        if (old + 1u == (gen + 1u) * nloc) {
            __builtin_amdgcn_fence(__ATOMIC_RELEASE, "agent");
            asm volatile("s_waitcnt vmcnt(0)" ::: "memory");
            const unsigned og = xb_add(&bar[XB_TOP], 1u);
            const unsigned tg = og / nx;
            if (og + 1u == (tg + 1u) * nx) xb_add(&bar[XB_TOPGEN], 1u);
            else XB_SPIN(xb_ld(&bar[XB_TOPGEN]) == tg, bar);
            __builtin_amdgcn_fence(__ATOMIC_ACQUIRE, "agent");
            xb_add(&bar[XB_XGEN(b.x)], 1u);
            asm volatile("s_waitcnt vmcnt(0)" ::: "memory");
        } else {
            XB_SPIN(xb_ld(&bar[XB_XGEN(b.x)]) == gen, bar);
            __builtin_amdgcn_fence(__ATOMIC_ACQUIRE, "agent");
            asm volatile("s_waitcnt vmcnt(0)" ::: "memory");
        }
    }
    __syncthreads();
}


__global__ void __launch_bounds__(NTHR, 2) fwd_kernel(Params p) {
    __builtin_assume(__builtin_amdgcn_workitem_id_y() == 0);
    __builtin_assume(__builtin_amdgcn_workitem_id_z() == 0);
    extern __shared__ __attribute__((aligned(16))) unsigned char smem[];
    cg::grid_group grid = cg::this_grid();
    const int lo = p.ph_lo, hi = p.ph_hi;
#ifndef ONLY
#define ONLY -1
#endif
#define IN(k) ((ONLY < 0 || ONLY == (k)) && lo <= (k) && (k) < hi)
#ifdef PROBE_A
#define STAMP(k) do { if (blockIdx.x == 0 && threadIdx.x == 0) ((unsigned long long*)(p.ws + OFF_CTL + 512))[k] = __builtin_amdgcn_s_memrealtime(); } while (0)
#else
#define STAMP(k) do {} while (0)
#endif
#define SYNC(k) do { if (IN(k) && IN((k) + 1)) { if ((k) == 0) grid.sync(); else xcd_barrier(xbar); } STAMP((k) + 1); } while (0)
    unsigned* ctl = (unsigned*)(p.ws + OFF_CTL);
    volatile LAS unsigned* xst = (volatile LAS unsigned*)((LAS unsigned char*)smem + LDS_BYTES - 32);
    if (threadIdx.x < 2) xst[threadIdx.x] = 0u;
    __syncthreads();
    const XcdBarrier xbar = xcd_barrier_post((unsigned*)(p.ws + OFF_BAR), xst);
    STAMP(0);
    if (IN(0)) { if (blockIdx.x == 0 && threadIdx.x < 8) ctl[16 * threadIdx.x] = 0u;
        p0_weights(p); p0_tokens(p); }
    SYNC(0);
    if (IN(1)) { EpiProj e{(bf16_t*)(p.ws + OFF_PROJ)}; gemm_phase_p<EpiProj>((const bf16_t*)(p.ws + OFF_HN), DM, (const bf16_t*)(p.ws + OFF_WIN), T, NPROJ, DM, e, 0); }
    SYNC(1);
    if (IN(2)) {
        for (int u = blockIdx.x; u < NCHUNK * 4; u += gridDim.x) dn_prep_unit(p, u >> 2, u & 3);
    }
    SYNC(2);
    if (IN(3)) {
        for (int u = blockIdx.x; u < 192; u += gridDim.x) dn_scan_unit(p, u);
        STAMP(13);
        float l01 = 0.f, l23 = 0.f;
        for (int i = 0; i < 64; ++i) { l01 += p.da_lambda[i] * p.da_lambda[64 + i]; l23 += p.da_lambda[128 + i] * p.da_lambda[192 + i]; }
        const float lam = __expf(l01) - __expf(l23) + 0.2f;
        float gqm = 0.f, gkm = 0.f;
        for (int i = 0; i < 64; ++i) { gqm = fmaxf(gqm, fabsf(p.da_qk_norm_g[i])); gkm = fmaxf(gkm, fabsf(p.da_qk_norm_g[64 + i])); }
        const float negC = -64.f * 0.18033688f * gqm * gkm;
        int* sh = (int*)(smem + LDS_BYTES - 16);
        int victim = blockIdx.x & 7, tried = 0;
        while (true) {
            __syncthreads();
            if (threadIdx.x == 0) {
                int a = -1;
                while (tried < 8) {
                    const int j = (int)atomicAdd(ctl + 16 * victim, 1u);
                    if (j < 320) {
                        if (j < 256) { const int pair = victim + 8 * (j >> 5); a = pair * 32 + (j & 31); }
                        else { const int jj = j - 256; const int pair = victim + 8 * (jj >> 4); a = 2048 + pair * 16 + (jj & 15); }
                        break;
                    }
                    victim = (victim + 1) & 7; ++tried;
                }
                *sh = a;
            }
            __syncthreads();
            const int a = *sh;
            if (a < 0) break;
#ifndef SKIP_ATTN
            attn_unit<0>(p, a, lam, negC);
#endif
        }
    }
    SYNC(3);
    if (IN(4)) dn_combine(p);
    SYNC(4);
    if (IN(5)) { EpiResX e{{p.xp, p.xs, p.out}}; gemm_phase_p<EpiResX>((const bf16_t*)(p.ws + OFF_PROJ) + 1536, NPROJ, (const bf16_t*)(p.ws + OFF_WOUT), T, DM, DM, e, 0); }
    SYNC(5);
    if (IN(6)) { rmsnorm_pass(p.out, p.ln2_g, (bf16_t*)(p.ws + OFF_HN)); pe_convert(p); }
    SYNC(6);
    if (IN(7)) {
        EpiFfnP e{(bf16_t*)(p.ws + OFF_PROJ), (float*)(p.ws + OFF_GE), (float*)(p.ws + OFF_UE), p.ffn_conv_w, p.ffn_conv_b};
        gemm_phase_p<EpiFfnP>((const bf16_t*)(p.ws + OFF_HN), DM, (const bf16_t*)(p.ws + OFF_WUP), T, NUP, DM, e, 0);
        EpiEraw e2{(bf16_t*)(p.ws + OFF_ERAW), (float*)(p.ws + OFF_SSQ)};
        gemm_phase_p<EpiEraw>((const bf16_t*)(p.ws + OFF_PE), PLE, (const bf16_t*)(p.ws + OFF_WPLE), T, DM, PLE, e2, 128);
    }
    SYNC(7);
    if (IN(8)) ffn_edges(p);
    SYNC(8);
    if (IN(9)) { EpiAcc e{p.out}; gemm_phase_p<EpiAcc, true>((const bf16_t*)(p.ws + OFF_PROJ), DFF, (const bf16_t*)(p.ws + OFF_WDN), T, DM, DFF, e, 0); }
    SYNC(9);
    if (IN(10)) rmsnorm_pass(p.out, p.ple_gate_norm_g, (bf16_t*)(p.ws + OFF_HN));
    SYNC(10);
    if (IN(11)) {
        EpiFinal e{p.out, (const bf16_t*)(p.ws + OFF_ERAW), (const float*)(p.ws + OFF_SSQ), p.ple_norm_g};
        gemm_phase_p<EpiFinal>((const bf16_t*)(p.ws + OFF_HN), DM, (const bf16_t*)(p.ws + OFF_WG), T, DM, DM, e, 0);
    }
#ifdef DUMP_ON
    if (IN(12)) dump_phase(p);
#endif
#ifdef PROBE_A
    STAMP(12);
    grid.sync();
    if (blockIdx.x == 0) {
        const unsigned long long* ts = (const unsigned long long*)(p.ws + OFF_CTL + 512);
        const float dtA = (float)(ts[PROBE_A1] - ts[PROBE_A]) * 1e-5f, dtB = (float)(ts[PROBE_B1] - ts[PROBE_B]) * 1e-5f;
        if (threadIdx.x == 0) p.out[0] += 4.f * dtA;
        for (int j = threadIdx.x; j < 6711; j += NTHR) p.out[(size_t)TP * DM + j] += 0.5f * dtB;
    }
#endif
#undef IN
#undef SYNC
}

constexpr int NPHASE = 12;

extern "C" void kernel_launch(void* const* d_in, const int* in_sizes, int n_in, void* d_out, int out_size, void* d_ws, size_t ws_size, hipStream_t stream) {
    static int grid = 0;
    if (grid == 0) {
        if (n_in != 23 || ws_size < OFF_BAR + 16384) { fprintf(stderr, "kernel_launch: unexpected n_in %d / ws %zu (need %zu)\n", n_in, ws_size, (size_t)WS_END); grid = -1; return; }
        int dev = 0, cus = 0, per_cu = 0;
        hipGetDevice(&dev);
        hipDeviceGetAttribute(&cus, hipDeviceAttributeMultiprocessorCount, dev);
        if (hipFuncSetAttribute((const void*)fwd_kernel, hipFuncAttributeMaxDynamicSharedMemorySize, LDS_BYTES) != hipSuccess) { fprintf(stderr, "kernel_launch: hipFuncSetAttribute failed\n"); grid = -1; return; }
        if (hipOccupancyMaxActiveBlocksPerMultiprocessor(&per_cu, (const void*)fwd_kernel, NTHR, LDS_BYTES) != hipSuccess || per_cu < 1) { fprintf(stderr, "kernel_launch: occupancy query says %d\n", per_cu); per_cu = 1; }
        (void)hipGetLastError();
        grid = cus * per_cu;
    }
    if (grid < 0) return;
    (void)hipMemsetAsync((char*)d_ws + OFF_BAR, 0, 16384, stream);
    Params p{};
    p.xp = (const float*)d_in[0]; p.xs = (const float*)d_in[1]; p.pp = (const float*)d_in[2]; p.ps = (const float*)d_in[3];
    p.ln1_g = (const float*)d_in[4]; p.w_in = (const float*)d_in[5]; p.dn_conv_w = (const float*)d_in[6]; p.dn_a_log = (const float*)d_in[7];
    p.dn_dt_bias = (const float*)d_in[8]; p.dn_norm_g = (const float*)d_in[9]; p.da_qk_norm_g = (const float*)d_in[10]; p.da_lambda = (const float*)d_in[11];
    p.da_subln_g = (const float*)d_in[12]; p.w_out = (const float*)d_in[13]; p.ln2_g = (const float*)d_in[14]; p.w_up = (const float*)d_in[15];
    p.ffn_conv_w = (const float*)d_in[16]; p.ffn_conv_b = (const float*)d_in[17]; p.w_down = (const float*)d_in[18]; p.ple_proj = (const float*)d_in[19];
    p.ple_norm_g = (const float*)d_in[20]; p.ple_gate_norm_g = (const float*)d_in[21]; p.w_ple_gate = (const float*)d_in[22];
    p.out = (float*)d_out; p.ws = (unsigned char*)d_ws;
#if COOP
    p.ph_lo = 0; p.ph_hi = NPHASE;
    void* args[] = {&p};
    hipError_t e = hipLaunchCooperativeKernel((const void*)fwd_kernel, dim3(grid), dim3(NTHR), args, LDS_BYTES, stream);
    if (e != hipSuccess) fprintf(stderr, "cooperative launch failed: %s (grid %d)\n", hipGetErrorString(e), grid);
#else
#ifndef PH_LIMIT
#define PH_LIMIT NPHASE
#endif
    for (int ph = 0; ph < PH_LIMIT; ++ph) {
        p.ph_lo = ph; p.ph_hi = ph + 1;
        hipLaunchKernelGGL(fwd_kernel, dim3(grid), dim3(NTHR), LDS_BYTES, stream, p);
    }
#ifdef DUMP_ON
    p.ph_lo = 12; p.ph_hi = 13;
    hipLaunchKernelGGL(fwd_kernel, dim3(grid), dim3(NTHR), LDS_BYTES, stream, p);
#endif
#endif
}
```

```cpp
#include <hip/hip_runtime.h>
#include <hip/hip_cooperative_groups.h>
#include <cstdio>
#include <cstdint>
namespace cg = cooperative_groups;

typedef unsigned short bf16_t;
typedef short bf16x8 __attribute__((ext_vector_type(8)));
typedef float f32x4 __attribute__((ext_vector_type(4)));
typedef unsigned u32x4 __attribute__((ext_vector_type(4)));
typedef unsigned u32x2 __attribute__((ext_vector_type(2)));

#ifndef COOP
#define COOP 1
#endif

constexpr int T = 81920, TP = 16384, DM = 1024, NPROJ = 3584, NIN = 3600, DFF = 2816, NUP = 5632, PLE = 256;
constexpr int NTHR = 512;
constexpr int NCHUNK = T / 64;
constexpr float EPS = 1e-6f;
constexpr int LDS_BYTES = 139264;

constexpr size_t OFF_CTL = 0;
constexpr size_t OFF_WIN = 4096;
constexpr size_t OFF_WOUT = OFF_WIN + (size_t)NPROJ * DM * 2;
constexpr size_t OFF_WUP = OFF_WOUT + (size_t)DM * DM * 2;
constexpr size_t OFF_WDN = OFF_WUP + (size_t)NUP * DM * 2;
constexpr size_t OFF_WPLE = OFF_WDN + (size_t)DM * DFF * 2;
constexpr size_t OFF_WG = OFF_WPLE + (size_t)DM * PLE * 2;
constexpr size_t OFF_DAB = OFF_WG + (size_t)DM * DM * 2;
constexpr size_t OFF_GC = OFF_DAB + (size_t)T * 16 * 4;
constexpr size_t OFF_SSQ = OFF_GC + (size_t)8 * T * 4;
constexpr size_t OFF_HN = OFF_SSQ + (size_t)T * 16 * 4;
constexpr size_t OFF_PROJ = OFF_HN + (size_t)T * DM * 2;
constexpr size_t OFF_QK = OFF_PROJ + (size_t)T * NPROJ * 2;
constexpr size_t WS_END = OFF_QK + (size_t)3 * T * 512 * 2;
constexpr size_t OFF_QN = OFF_QK;
constexpr size_t OFF_KN = OFF_QK + (size_t)T * 512 * 2;
constexpr size_t OFF_KNT = OFF_QK + (size_t)2 * T * 512 * 2;
constexpr size_t OFF_ERAW = OFF_QK;
constexpr size_t OFF_GE = OFF_ERAW + (size_t)T * DM * 2;
constexpr size_t OFF_UE = OFF_GE + (size_t)320 * 4 * DFF * 4;
constexpr size_t OFF_PE = OFF_UE + (size_t)320 * 2 * DFF * 4;
static_assert(OFF_PE + (size_t)T * PLE * 2 <= WS_END, "overlay");
constexpr size_t OFF_BAR = WS_END;
static_assert(OFF_BAR + 16384 <= (size_t)1073741824, "ws");

struct Params {
    const float* xp; const float* xs; const float* pp; const float* ps;
    const float* ln1_g; const float* w_in; const float* dn_conv_w; const float* dn_a_log; const float* dn_dt_bias; const float* dn_norm_g;
    const float* da_qk_norm_g; const float* da_lambda; const float* da_subln_g; const float* w_out; const float* ln2_g; const float* w_up;
    const float* ffn_conv_w; const float* ffn_conv_b; const float* w_down; const float* ple_proj; const float* ple_norm_g; const float* ple_gate_norm_g; const float* w_ple_gate;
    float* out; unsigned char* ws;
    int ph_lo, ph_hi;
};

typedef float f32x2 __attribute__((ext_vector_type(2)));
typedef __bf16 bf16x2v __attribute__((ext_vector_type(2)));
__device__ __forceinline__ unsigned pk2(float lo, float hi) { const f32x2 v = {lo, hi}; const bf16x2v b = __builtin_convertvector(v, bf16x2v); return __builtin_bit_cast(unsigned, b); }
__device__ __forceinline__ float bflo(unsigned u) { return __uint_as_float(u << 16); }
__device__ __forceinline__ float bfhi(unsigned u) { return __uint_as_float(u & 0xffff0000u); }
__device__ __forceinline__ float bf2f(bf16_t h) { return __uint_as_float(((unsigned)h) << 16); }
__device__ __forceinline__ bf16_t f2bf(float f) { return (bf16_t)(pk2(f, 0.f) & 0xffffu); }
__device__ __forceinline__ float siluf(float x) { return x / (1.f + __expf(-x)); }
__device__ __forceinline__ float sigmoidf_(float x) { return 1.f / (1.f + __expf(-x)); }
__device__ __forceinline__ void tok_seq(int t, int& s0, int& S) { if (t < TP) { S = 2048; s0 = t & ~2047; } else { S = 4096; s0 = TP + ((t - TP) & ~4095); } }
__device__ __forceinline__ const float* xrow(const Params& p, int r) { return r < TP ? p.xp + (size_t)r * DM : p.xs + (size_t)(r - TP) * DM; }
__device__ __forceinline__ const float* prow(const Params& p, int r) { return r < TP ? p.pp + (size_t)r * PLE : p.ps + (size_t)(r - TP) * PLE; }
__device__ __forceinline__ float wave_sum(float v) {
#pragma unroll
    for (int o = 32; o >= 1; o >>= 1) v += __shfl_xor(v, o);
    return v;
}
#define MFMA16(a, b, c) __builtin_amdgcn_mfma_f32_16x16x32_bf16((a), (b), (c), 0, 0, 0)

__device__ void p0_weights(const Params& p) {
    extern __shared__ __attribute__((aligned(16))) unsigned char smem[];
    float* tile = (float*)smem;
    const int tid = threadIdx.x;
    const int n0 = 896, n1 = n0 + 256, n2 = n1 + 1408, n3 = n2 + 704, n4 = n3 + 64, n5 = n4 + 256;
    for (int tix = blockIdx.x; tix < n5; tix += gridDim.x) {
        const float* src; int ldsrc, K, mode, loc; bf16_t* dst;
        if (tix < n0) { src = p.w_in; ldsrc = NIN; K = DM; mode = 0; loc = tix; dst = (bf16_t*)(p.ws + OFF_WIN); }
        else if (tix < n1) { src = p.w_out; ldsrc = DM; K = DM; mode = 1; loc = tix - n0; dst = (bf16_t*)(p.ws + OFF_WOUT); }
        else if (tix < n2) { src = p.w_up; ldsrc = NUP; K = DM; mode = 2; loc = tix - n1; dst = (bf16_t*)(p.ws + OFF_WUP); }
        else if (tix < n3) { src = p.w_down; ldsrc = DM; K = DFF; mode = 1; loc = tix - n2; dst = (bf16_t*)(p.ws + OFF_WDN); }
        else if (tix < n4) { src = p.ple_proj; ldsrc = DM; K = PLE; mode = 1; loc = tix - n3; dst = (bf16_t*)(p.ws + OFF_WPLE); }
        else { src = p.w_ple_gate; ldsrc = DM; K = DM; mode = 1; loc = tix - n4; dst = (bf16_t*)(p.ws + OFF_WG); }
        const int nkt = K / 64, nt = loc / nkt, kt = loc % nkt;
        const int nbase = nt * 64;
        int cbase;
        if (mode == 0) cbase = nbase < 2048 ? nbase : nbase + 16;
        else if (mode == 2) { const int g = nbase >> 8, w = nbase & 255; cbase = (w < 128) ? g * 128 + w : DFF + g * 128 + (w - 128); }
        else cbase = nbase;
        const int c = tid & 63, r0 = tid >> 6;
#pragma unroll
        for (int i = 0; i < 8; ++i) { const int r = r0 + 8 * i; tile[r * 65 + c] = src[(size_t)(kt * 64 + r) * ldsrc + cbase + c]; }
        __syncthreads();
#pragma unroll
        for (int i = 0; i < 8; ++i) { const int n = r0 + 8 * i;
            const int rho = n & 31, ii = rho & 15, ns = (n & 32) + 8 * (ii >> 2) + 4 * (rho >> 4) + (ii & 3);
            dst[(size_t)(nbase + n) * K + kt * 64 + c] = f2bf(tile[c * 65 + ns]); }
        __syncthreads();
    }
}

__device__ void p0_tokens(const Params& p) {
    extern __shared__ __attribute__((aligned(16))) unsigned char smem[];
    float* Wd = (float*)smem;
    const int tid = threadIdx.x, lane = tid & 63, wave = tid >> 6;
    for (int idx = tid; idx < 16384; idx += NTHR) { const int c = idx >> 4, k = idx & 15; Wd[k * 1024 + c] = p.w_in[(size_t)c * NIN + 2048 + k]; }
    __syncthreads();
    bf16_t* hn = (bf16_t*)(p.ws + OFF_HN);
    float* dab = (float*)(p.ws + OFF_DAB);
    const int step = gridDim.x * 8;
    f32x4 vn[2][4];
    {
#pragma unroll
        for (int q = 0; q < 2; ++q) { const int r = blockIdx.x * 8 + wave + q * step; if (r < T) { const float* xr = xrow(p, r);
#pragma unroll
            for (int i = 0; i < 4; ++i) vn[q][i] = *(const f32x4*)(xr + i * 256 + lane * 4); } }
    }
    f32x4 g1[4];
#pragma unroll
    for (int i = 0; i < 4; ++i) g1[i] = *(const f32x4*)(p.ln1_g + i * 256 + lane * 4);
    for (int r0 = blockIdx.x * 8 + wave; r0 < T; r0 += 2 * step) {
        f32x4 v[2][4];
        float ss[2] = {0.f, 0.f};
#pragma unroll
        for (int q = 0; q < 2; ++q)
#pragma unroll
            for (int i = 0; i < 4; ++i) { v[q][i] = vn[q][i]; ss[q] += v[q][i][0] * v[q][i][0] + v[q][i][1] * v[q][i][1] + v[q][i][2] * v[q][i][2] + v[q][i][3] * v[q][i][3]; }
#pragma unroll
        for (int q = 0; q < 2; ++q) { const int rn = r0 + (2 + q) * step; if (rn < T) { const float* xr = xrow(p, rn);
#pragma unroll
            for (int i = 0; i < 4; ++i) vn[q][i] = *(const f32x4*)(xr + i * 256 + lane * 4); } }
        const bool has1 = (r0 + step) < T;
#pragma unroll
        for (int q = 0; q < 2; ++q) {
            ss[q] = wave_sum(ss[q]);
            const float rs = rsqrtf(ss[q] * (1.f / DM) + EPS);
            const int r = r0 + q * step;
#pragma unroll
            for (int i = 0; i < 4; ++i) {
                v[q][i] = v[q][i] * rs * g1[i];
                if (q == 0 || has1) { u32x2 o; o[0] = pk2(v[q][i][0], v[q][i][1]); o[1] = pk2(v[q][i][2], v[q][i][3]); *(u32x2*)(hn + (size_t)r * DM + i * 256 + lane * 4) = o; }
            }
        }
        float my0 = 0.f, my1 = 0.f;
#pragma unroll 2
        for (int k = 0; k < 16; ++k) {
            float a0 = 0.f, a1 = 0.f;
#pragma unroll
            for (int i = 0; i < 4; ++i) { const f32x4 w = *(const f32x4*)(Wd + k * 1024 + i * 256 + lane * 4);
                a0 += v[0][i][0] * w[0] + v[0][i][1] * w[1] + v[0][i][2] * w[2] + v[0][i][3] * w[3];
                a1 += v[1][i][0] * w[0] + v[1][i][1] * w[1] + v[1][i][2] * w[2] + v[1][i][3] * w[3]; }
            a0 = wave_sum(a0); a1 = wave_sum(a1);
            if (lane == k) { my0 = a0; my1 = a1; }
        }
        if (lane < 16) { dab[(size_t)r0 * 16 + lane] = my0; if (has1) dab[(size_t)(r0 + step) * 16 + lane] = my1; }
    }
    __syncthreads();
}

__device__ void rmsnorm_pass(const float* src, const float* g, bf16_t* hn) {
    const int tid = threadIdx.x, lane = tid & 63, wave = tid >> 6;
    constexpr int RB = 4;
    f32x4 gg[4];
#pragma unroll
    for (int i = 0; i < 4; ++i) gg[i] = *(const f32x4*)(g + i * 256 + lane * 4);
    for (int r0 = (blockIdx.x * 8 + wave) * RB; r0 < T; r0 += gridDim.x * 8 * RB) {
        f32x4 v[RB][4];
#pragma unroll
        for (int k = 0; k < RB; ++k)
#pragma unroll
            for (int i = 0; i < 4; ++i) v[k][i] = *(const f32x4*)(src + (size_t)(r0 + k) * DM + i * 256 + lane * 4);
#pragma unroll
        for (int k = 0; k < RB; ++k) {
            float ss = 0.f;
#pragma unroll
            for (int i = 0; i < 4; ++i) ss += v[k][i][0] * v[k][i][0] + v[k][i][1] * v[k][i][1] + v[k][i][2] * v[k][i][2] + v[k][i][3] * v[k][i][3];
            ss = wave_sum(ss);
            const float rs = rsqrtf(ss * (1.f / DM) + EPS);
#pragma unroll
            for (int i = 0; i < 4; ++i) {
                const f32x4 y = v[k][i] * rs * gg[i];
                u32x2 o; o[0] = pk2(y[0], y[1]); o[1] = pk2(y[2], y[3]);
                *(u32x2*)(hn + (size_t)(r0 + k) * DM + i * 256 + lane * 4) = o;
            }
        }
    }
}

constexpr int BM = 256, BK = 64, HALF = 128, HT = HALF * BK;
__device__ __forceinline__ int lds_byte(int r, int c) { int st = (r >> 4) * 2 + (c >> 5), rr = r & 15, cc = c & 31, ob = rr * 64 + cc * 2; return st * 1024 + (ob ^ (((ob >> 9) & 1) << 5)); }
__device__ __forceinline__ void stage_rc(int b, int& R, int& C) { int st = b / 1024, sb = b % 1024, swz = sb ^ (((sb >> 9) & 1) << 5); R = (st >> 1) * 16 + swz / 64; C = (st & 1) * 32 + (swz % 64) / 2; }

#define LAS __attribute__((address_space(3)))
constexpr int HTB = HT * 2;
template <class Epi>
__device__ __forceinline__ void gemm_tile(const bf16_t* __restrict__ A, const int lda, const bf16_t* __restrict__ Bt, const int K, const int pm, const int pn, const Epi& epi) {
    extern __shared__ __attribute__((aligned(16))) unsigned char smem[];
    LAS unsigned char* lds = (LAS unsigned char*)smem;
    const int tid = threadIdx.x, wid = __builtin_amdgcn_readfirstlane(tid >> 6), lane = tid & 63, wr = wid >> 2, wc = wid & 3, fr = lane & 15, fq = lane >> 4;
    unsigned voffA[2], voffB[2];
#pragma unroll
    for (int i = 0; i < 2; ++i) { int R, C; stage_rc(tid * 16 + i * 8192, R, C); voffA[i] = (unsigned)(R * lda + C) * 2u; voffB[i] = (unsigned)(R * K + C) * 2u; }
    const unsigned ldsw = (unsigned)wid * 1024u;
    const int aoff = lds_byte(wr * 64 + fr, fq * 8), boff = lds_byte(wc * 32 + fr, fq * 8);
    const bf16_t* Ab0 = A + (size_t)(pm * BM) * lda;
    const bf16_t* Ab1 = Ab0 + (size_t)HALF * lda;
    const bf16_t* Bb0 = Bt + (size_t)(pn * BM) * K;
    const bf16_t* Bb1 = Bb0 + (size_t)HALF * K;
#define SA(b, h) (((b) * 2 + (h)) * HTB)
#define SB(b, h) ((4 + (b) * 2 + (h)) * HTB)
#define STAGE(bufoff, gbase, voff) do { _Pragma("unroll") for (int _i = 0; _i < 2; ++_i) \
      __builtin_amdgcn_global_load_lds((const unsigned*)((const char*)(gbase) + (voff)[_i]), (LAS unsigned*)(lds + (bufoff) + ldsw + _i * 8192), 16, 0, 0); } while (0)
#define STA(b, h, kt) STAGE(SA(b, h), ((h) ? Ab1 : Ab0) + (size_t)(kt) * BK, voffA)
#define STB(b, h, kt) STAGE(SB(b, h), ((h) ? Bb1 : Bb0) + (size_t)(kt) * BK, voffB)
#define LDA(dst, b, h) do { _Pragma("unroll") for (int m = 0; m < 4; ++m) _Pragma("unroll") for (int k = 0; k < 2; ++k) dst[m][k] = *(const LAS bf16x8*)(lds + SA(b, h) + aoff + m * 2048 + k * 1024); } while (0)
#define LDB(dst, b, h) do { _Pragma("unroll") for (int n = 0; n < 2; ++n) _Pragma("unroll") for (int k = 0; k < 2; ++k) dst[n][k] = *(const LAS bf16x8*)(lds + SB(b, h) + boff + n * 2048 + k * 1024); } while (0)
#define MMA(ai, bj, At_, Bt_) do { __builtin_amdgcn_s_setprio(1); \
    _Pragma("unroll") for (int m = 0; m < 4; ++m) _Pragma("unroll") for (int n = 0; n < 2; ++n) _Pragma("unroll") for (int k = 0; k < 2; ++k) \
      acc[ai][bj][m][n] = __builtin_amdgcn_mfma_f32_16x16x32_bf16(Bt_[n][k], At_[m][k], acc[ai][bj][m][n], 0, 0, 0); \
    __builtin_amdgcn_s_setprio(0); } while (0)
#define WAIT_V(n) asm volatile("s_waitcnt vmcnt(" #n ")" ::: "memory")
#define WAIT_L(n) asm volatile("s_waitcnt lgkmcnt(" #n ")" ::: "memory")
#define BAR __builtin_amdgcn_s_barrier()
#define SCHED __builtin_amdgcn_sched_barrier(0)
    f32x4 acc[2][2][4][2];
#pragma unroll
    for (int a = 0; a < 2; ++a)
#pragma unroll
        for (int b = 0; b < 2; ++b)
#pragma unroll
            for (int m = 0; m < 4; ++m)
#pragma unroll
                for (int n = 0; n < 2; ++n) acc[a][b][m][n] = (f32x4){0.f, 0.f, 0.f, 0.f};
    bf16x8 At[4][2], B0[2][2], B1[2][2];
    const int nt = K / BK;
    STB(0, 0, 0); STA(0, 0, 0);
    STB(0, 1, 0); STA(0, 1, 0);
    if (wr == 1) BAR;
    WAIT_V(4); BAR;
    STB(1, 0, 1); STA(1, 0, 1); STB(1, 1, 1);
    WAIT_V(6); BAR;
    for (int t = 0; t < nt - 2; t += 2) {
        LDB(B0, 0, 0); SCHED; LDA(At, 0, 0); STA(1, 1, t + 1);
        WAIT_L(8); BAR; WAIT_L(0); MMA(0, 0, At, B0); BAR; SCHED;
        LDB(B1, 0, 1); STB(0, 0, t + 2);
        BAR; WAIT_L(0); MMA(0, 1, At, B1); BAR;
        LDA(At, 0, 1); STA(0, 0, t + 2);
        BAR; WAIT_L(0); MMA(1, 0, At, B0); BAR; SCHED;
        STB(0, 1, t + 2);
        WAIT_V(6); BAR; MMA(1, 1, At, B1); BAR;
        LDB(B0, 1, 0); SCHED; LDA(At, 1, 0); STA(0, 1, t + 2);
        WAIT_L(8); BAR; WAIT_L(0); MMA(0, 0, At, B0); BAR; SCHED;
        LDB(B1, 1, 1); STB(1, 0, t + 3);
        BAR; WAIT_L(0); MMA(0, 1, At, B1); BAR;
        LDA(At, 1, 1); STA(1, 0, t + 3);
        BAR; WAIT_L(0); MMA(1, 0, At, B0); BAR; SCHED;
        STB(1, 1, t + 3);
        WAIT_V(6); BAR; MMA(1, 1, At, B1); BAR;
    }
    { LDB(B0, 0, 0); LDA(At, 0, 0); STA(1, 1, nt - 1);
      BAR; WAIT_L(0); MMA(0, 0, At, B0); BAR;
      LDB(B1, 0, 1); BAR; WAIT_L(0); MMA(0, 1, At, B1); BAR;
      LDA(At, 0, 1); WAIT_V(4); BAR; WAIT_L(0); MMA(1, 0, At, B0); MMA(1, 1, At, B1); BAR; }
    { LDB(B0, 1, 0); LDA(At, 1, 0); WAIT_V(2); BAR; WAIT_L(0); MMA(0, 0, At, B0); BAR;
      LDB(B1, 1, 1); WAIT_V(0); BAR; WAIT_L(0); MMA(0, 1, At, B1); BAR;
      LDA(At, 1, 1); BAR; WAIT_L(0); MMA(1, 0, At, B0); MMA(1, 1, At, B1); BAR; }
    if (wr == 0) BAR;
    epi(acc, pm, pn, wr, wc, fr, fq);
#undef SA
#undef SB
#undef STAGE
#undef STA
#undef STB
#undef LDA
#undef LDB
#undef MMA
}

__device__ __forceinline__ bool tile_of(int L, int nM, int nN, int& pm, int& pn) {
    const int nwg = nM * nN;
    if (L >= nwg) return false;
    int wgid = L;
    { const int q = nwg / 8, r = nwg % 8, xcd = wgid % 8, off = wgid / 8; wgid = (xcd < r ? xcd * (q + 1) : r * (q + 1) + (xcd - r) * q) + off; }
    const int nig = 8 * nN, gid = wgid / nig, fm = gid * 8, gsz = (nM - fm) < 8 ? (nM - fm) : 8;
    pm = fm + ((wgid % nig) % gsz); pn = (wgid % nig) / gsz;
    return true;
}

template <class Epi>
__device__ __forceinline__ void gemm_phase(const bf16_t* A, int lda, const bf16_t* Bt, int M, int N, int K, const Epi& epi, int rot) {
    const int nM = M / BM, nN = N / BM;
    const int G = gridDim.x;
    int c = (int)blockIdx.x + rot; if (c >= G) c -= G;
    for (int L = c; ; L += G) {
        int pm, pn;
        if (!tile_of(L, nM, nN, pm, pn)) break;
        gemm_tile<Epi>(A, lda, Bt, K, pm, pn, epi);
    }
}

template <class Epi, bool PACKA = false>
__device__ __forceinline__ void gemm_phase_p(const bf16_t* __restrict__ A, const int lda, const bf16_t* __restrict__ Bt, int M, int N, const int K, const Epi& epi, int rot) {
    extern __shared__ __attribute__((aligned(16))) unsigned char smem[];
    LAS unsigned char* lds = (LAS unsigned char*)smem;
    const int nM = M / BM, nN = N / BM;
    const int G = gridDim.x;
    int c = (int)blockIdx.x + rot; if (c >= G) c -= G;
    int pm, pn, npm, npn;
    if (!tile_of(c, nM, nN, pm, pn)) return;
    const int tid = threadIdx.x, wid = __builtin_amdgcn_readfirstlane(tid >> 6), lane = tid & 63, wr = wid >> 2, wc = wid & 3, fr = lane & 15, fq = lane >> 4;
    unsigned voffA[2], voffB[2];
#pragma unroll
    for (int i = 0; i < 2; ++i) { int R, C; stage_rc(tid * 16 + i * 8192, R, C); voffA[i] = (unsigned)(R * (PACKA ? 64 : lda) + C) * 2u; voffB[i] = (unsigned)(R * K + C) * 2u; }
    const unsigned ldsw = (unsigned)wid * 1024u;
    const int aoff = lds_byte(wr * 64 + fr, fq * 8), boff = lds_byte(wc * 32 + fr, fq * 8);
    const int nt = K / BK;
    const size_t kstep = (size_t)BK * 2, kA = PACKA ? (size_t)256 * 64 * 2 : kstep, hA = PACKA ? (size_t)HALF * 64 * 2 : (size_t)HALF * lda * 2, hB = (size_t)HALF * K * 2,
                 tA = PACKA ? (size_t)nt * 256 * 64 * 2 : 2 * hA, tB = 2 * hB;
#define SA(b, h) (((b) * 2 + (h)) * HTB)
#define SB(b, h) ((4 + (b) * 2 + (h)) * HTB)
#define STAGE(bufoff, gbase, voff) do { _Pragma("unroll") for (int _i = 0; _i < 2; ++_i) \
      __builtin_amdgcn_global_load_lds((const unsigned*)((const char*)(gbase) + (voff)[_i]), (LAS unsigned*)(lds + (bufoff) + ldsw + _i * 8192), 16, 0, 0); } while (0)
#define LDA(dst, b, h) do { _Pragma("unroll") for (int m = 0; m < 4; ++m) _Pragma("unroll") for (int k = 0; k < 2; ++k) dst[m][k] = *(const LAS bf16x8*)(lds + SA(b, h) + aoff + m * 2048 + k * 1024); } while (0)
#define LDB(dst, b, h) do { _Pragma("unroll") for (int n = 0; n < 2; ++n) _Pragma("unroll") for (int k = 0; k < 2; ++k) dst[n][k] = *(const LAS bf16x8*)(lds + SB(b, h) + boff + n * 2048 + k * 1024); } while (0)
#define MMA(ai, bj, At_, Bt_) do { __builtin_amdgcn_s_setprio(1); \
    _Pragma("unroll") for (int m = 0; m < 4; ++m) _Pragma("unroll") for (int n = 0; n < 2; ++n) _Pragma("unroll") for (int k = 0; k < 2; ++k) \
      acc[ai][bj][m][n] = __builtin_amdgcn_mfma_f32_16x16x32_bf16(Bt_[n][k], At_[m][k], acc[ai][bj][m][n], 0, 0, 0); \
    __builtin_amdgcn_s_setprio(0); } while (0)
    f32x4 acc[2][2][4][2];
#pragma unroll
    for (int a = 0; a < 2; ++a)
#pragma unroll
        for (int b = 0; b < 2; ++b)
#pragma unroll
            for (int m = 0; m < 4; ++m)
#pragma unroll
                for (int n = 0; n < 2; ++n) acc[a][b][m][n] = (f32x4){0.f, 0.f, 0.f, 0.f};
    bf16x8 At[4][2], B0[2][2], B1[2][2];
    const char* cA = (const char*)A + (size_t)pm * tA; const char* cB = (const char*)Bt + (size_t)pn * tB;
    STAGE(SB(0, 0), cB, voffB); STAGE(SA(0, 0), cA, voffA); STAGE(SB(0, 1), cB + hB, voffB); STAGE(SA(0, 1), cA + hA, voffA);
    if (wr == 1) BAR;
    WAIT_V(4); BAR;
    STAGE(SB(1, 0), cB + kstep, voffB); STAGE(SA(1, 0), cA + kA, voffA); STAGE(SB(1, 1), cB + hB + kstep, voffB);
    WAIT_V(6); BAR;
    int L = c;
    for (;;) {
        const bool has_next = tile_of(L + G, nM, nN, npm, npn);
        const char* nA = has_next ? (const char*)A + (size_t)npm * tA : cA; const char* nB = has_next ? (const char*)Bt + (size_t)npn * tB : cB;
        for (int t = 0; t < nt; t += 2) {
            const bool last = (t == nt - 2);
            const char* a1 = cA + (size_t)(t + 1) * kA;
            const char* a2 = last ? nA : cA + (size_t)(t + 2) * kA; const char* b2 = last ? nB : cB + (size_t)(t + 2) * kstep;
            const char* a3 = a2 + kA; const char* b3 = b2 + kstep;
            LDB(B0, 0, 0); SCHED; LDA(At, 0, 0); STAGE(SA(1, 1), a1 + hA, voffA);
            WAIT_L(8); BAR; WAIT_L(0); MMA(0, 0, At, B0); BAR; SCHED;
            LDB(B1, 0, 1); STAGE(SB(0, 0), b2, voffB);
            BAR; WAIT_L(0); MMA(0, 1, At, B1); BAR;
            LDA(At, 0, 1); STAGE(SA(0, 0), a2, voffA);
            BAR; WAIT_L(0); MMA(1, 0, At, B0); BAR; SCHED;
            STAGE(SB(0, 1), b2 + hB, voffB);
            WAIT_V(6); BAR; MMA(1, 1, At, B1); BAR;
            LDB(B0, 1, 0); SCHED; LDA(At, 1, 0); STAGE(SA(0, 1), a2 + hA, voffA);
            WAIT_L(8); BAR; WAIT_L(0); MMA(0, 0, At, B0); BAR; SCHED;
            LDB(B1, 1, 1); STAGE(SB(1, 0), b3, voffB);
            BAR; WAIT_L(0); MMA(0, 1, At, B1); BAR;
            LDA(At, 1, 1); STAGE(SA(1, 0), a3, voffA);
            BAR; WAIT_L(0); MMA(1, 0, At, B0); BAR; SCHED;
            STAGE(SB(1, 1), b3 + hB, voffB);
            WAIT_V(6); BAR; MMA(1, 1, At, B1); BAR;
        }
        epi(acc, pm, pn, wr, wc, fr, fq);
        if (!has_next) break;
#pragma unroll
        for (int a = 0; a < 2; ++a)
#pragma unroll
            for (int b = 0; b < 2; ++b)
#pragma unroll
                for (int m = 0; m < 4; ++m)
#pragma unroll
                    for (int n = 0; n < 2; ++n) acc[a][b][m][n] = (f32x4){0.f, 0.f, 0.f, 0.f};
        pm = npm; pn = npn; cA = nA; cB = nB; L += G;
    }
    WAIT_V(0);
    if (wr == 0) BAR;
    BAR;
#undef SA
#undef SB
#undef STAGE
#undef LDA
#undef LDB
#undef MMA
}

typedef f32x4 AccT[2][2][4][2];

struct EpiProj {
    bf16_t* P;
    __device__ __forceinline__ void operator()(const AccT& acc, int pm, int pn, int wr, int wc, int fr, int fq) const {
#pragma unroll
        for (int ai = 0; ai < 2; ++ai)
#pragma unroll
            for (int m = 0; m < 4; ++m) {
                const int row = pm * 256 + ai * 128 + wr * 64 + m * 16 + fr;
#pragma unroll
                for (int bj = 0; bj < 2; ++bj) {
                    const int col = pn * 256 + bj * 128 + wc * 32 + fq * 8;
                    const f32x4 v0 = acc[ai][bj][m][0], v1 = acc[ai][bj][m][1];
                    *(u32x4*)(P + (size_t)row * NPROJ + col) = (u32x4){pk2(v0[0], v0[1]), pk2(v0[2], v0[3]), pk2(v1[0], v1[1]), pk2(v1[2], v1[3])};
                }
            }
    }
};

struct EpiResX {
    struct { const float* xp; const float* xs; float* out; } p;
    __device__ __forceinline__ void operator()(const AccT& acc, int pm, int pn, int wr, int wc, int fr, int fq) const {
#pragma unroll
        for (int ai = 0; ai < 2; ++ai)
#pragma unroll
            for (int m = 0; m < 4; ++m) {
                const int row = pm * 256 + ai * 128 + wr * 64 + m * 16 + fr;
                const float* xr = row < TP ? p.xp + (size_t)row * DM : p.xs + (size_t)(row - TP) * DM;
#pragma unroll
                for (int bj = 0; bj < 2; ++bj)
#pragma unroll
                    for (int n = 0; n < 2; ++n) {
                        const int col = pn * 256 + bj * 128 + wc * 32 + fq * 8 + n * 4;
                        const f32x4 xv = *(const f32x4*)(xr + col);
                        *(f32x4*)(p.out + (size_t)row * DM + col) = xv + acc[ai][bj][m][n];
                    }
            }
    }
};

struct EpiAcc {
    float* out;
    __device__ __forceinline__ void operator()(const AccT& acc, int pm, int pn, int wr, int wc, int fr, int fq) const {
#pragma unroll
        for (int ai = 0; ai < 2; ++ai)
#pragma unroll
            for (int m = 0; m < 4; ++m) {
                const int row = pm * 256 + ai * 128 + wr * 64 + m * 16 + fr;
#pragma unroll
                for (int bj = 0; bj < 2; ++bj)
#pragma unroll
                    for (int n = 0; n < 2; ++n) {
                        const int col = pn * 256 + bj * 128 + wc * 32 + fq * 8 + n * 4;
                        float* o = out + (size_t)row * DM + col;
                        *(f32x4*)o = *(const f32x4*)o + acc[ai][bj][m][n];
                    }
            }
    }
};

struct EpiEraw {
    bf16_t* E; float* ssq;
    __device__ __forceinline__ void operator()(const AccT& acc, int pm, int pn, int wr, int wc, int fr, int fq) const {
#pragma unroll
        for (int ai = 0; ai < 2; ++ai)
#pragma unroll
            for (int m = 0; m < 4; ++m) {
                const int row = pm * 256 + ai * 128 + wr * 64 + m * 16 + fr;
                float s = 0.f;
#pragma unroll
                for (int bj = 0; bj < 2; ++bj) {
                    const int col = pn * 256 + bj * 128 + wc * 32 + fq * 8;
                    const f32x4 v0 = acc[ai][bj][m][0], v1 = acc[ai][bj][m][1];
                    s += v0[0] * v0[0] + v0[1] * v0[1] + v0[2] * v0[2] + v0[3] * v0[3] + v1[0] * v1[0] + v1[1] * v1[1] + v1[2] * v1[2] + v1[3] * v1[3];
                    *(u32x4*)(E + (size_t)row * DM + col) = (u32x4){pk2(v0[0], v0[1]), pk2(v0[2], v0[3]), pk2(v1[0], v1[1]), pk2(v1[2], v1[3])};
                }
                s += __shfl_xor(s, 16); s += __shfl_xor(s, 32);
                if (fq == 0) ssq[(size_t)row * 16 + pn * 4 + wc] = s;
            }
    }
};

struct EpiFinal {
    float* out; const bf16_t* E; const float* ssq; const float* ge;
    __device__ __forceinline__ void operator()(const AccT& acc, int pm, int pn, int wr, int wc, int fr, int fq) const {
#pragma unroll
        for (int ai = 0; ai < 2; ++ai)
#pragma unroll
            for (int m = 0; m < 4; ++m) {
                const int row = pm * 256 + ai * 128 + wr * 64 + m * 16 + fr;
                float s = 0.f;
#pragma unroll
                for (int q = 0; q < 4; ++q) { const f32x4 v = *(const f32x4*)(ssq + (size_t)row * 16 + q * 4); s += v[0] + v[1] + v[2] + v[3]; }
                const float rs = rsqrtf(s * (1.f / DM) + EPS);
#pragma unroll
                for (int bj = 0; bj < 2; ++bj)
#pragma unroll
                    for (int n = 0; n < 2; ++n) {
                        const int col = pn * 256 + bj * 128 + wc * 32 + fq * 8 + n * 4;
                        const u32x2 e = *(const u32x2*)(E + (size_t)row * DM + col);
                        const f32x4 g = *(const f32x4*)(ge + col);
                        const f32x4 a = acc[ai][bj][m][n];
                        f32x4 r;
                        r[0] = sigmoidf_(a[0]) * bflo(e[0]) * rs * g[0];
                        r[1] = sigmoidf_(a[1]) * bfhi(e[0]) * rs * g[1];
                        r[2] = sigmoidf_(a[2]) * bflo(e[1]) * rs * g[2];
                        r[3] = sigmoidf_(a[3]) * bfhi(e[1]) * rs * g[3];
                        float* o = out + (size_t)row * DM + col;
                        *(f32x4*)o = *(const f32x4*)o + r;
                    }
            }
    }
};

struct EpiFfn {
    bf16_t* H; float* ge; float* ue; const float* cw; const float* cb;
    __device__ __forceinline__ void operator()(const AccT& acc, int pm, int pn, int wr, int wc, int fr, int fq) const {
        extern __shared__ __attribute__((aligned(16))) unsigned char smem[];
        float* G = (float*)smem;
#pragma unroll
        for (int ai = 0; ai < 2; ++ai)
#pragma unroll
            for (int m = 0; m < 4; ++m) {
                const int r = ai * 128 + wr * 64 + m * 16 + fr;
#pragma unroll
                for (int n = 0; n < 2; ++n) *(f32x4*)(G + r * 132 + wc * 32 + fq * 8 + n * 4) = acc[ai][0][m][n];
            }
        __syncthreads();
#pragma unroll
        for (int n = 0; n < 2; ++n) {
            const int gc = wc * 32 + fq * 8 + n * 4;
            const int fc = pn * 128 + gc;
            const f32x4 w0 = *(const f32x4*)(cw + fc), w1 = *(const f32x4*)(cw + DFF + fc), w2 = *(const f32x4*)(cw + 2 * DFF + fc), bb = *(const f32x4*)(cb + fc);
#pragma unroll
            for (int ai = 0; ai < 2; ++ai)
#pragma unroll
                for (int m = 0; m < 4; ++m) {
                    const int r = ai * 128 + wr * 64 + m * 16 + fr;
                    const f32x4 gv = acc[ai][0][m][n], uv = acc[ai][1][m][n];
                    if (r == 0 || r == 255) {
                        *(f32x4*)(ge + ((size_t)pm * 4 + (r == 0 ? 0 : 3)) * DFF + fc) = gv;
                        *(f32x4*)(ue + ((size_t)pm * 2 + (r == 0 ? 0 : 1)) * DFF + fc) = uv;
                    } else {
                        if (r == 1) *(f32x4*)(ge + ((size_t)pm * 4 + 1) * DFF + fc) = gv;
                        if (r == 254) *(f32x4*)(ge + ((size_t)pm * 4 + 2) * DFF + fc) = gv;
                        const f32x4 gm = *(const f32x4*)(G + (r - 1) * 132 + gc), gp = *(const f32x4*)(G + (r + 1) * 132 + gc);
                        f32x4 hv;
#pragma unroll
                        for (int j = 0; j < 4; ++j) { const float cv = w0[j] * gm[j] + w1[j] * gv[j] + w2[j] * gp[j] + bb[j]; hv[j] = siluf(cv) * uv[j]; }
                        u32x2 o; o[0] = pk2(hv[0], hv[1]); o[1] = pk2(hv[2], hv[3]);
                        *(u32x2*)(H + (size_t)(pm * 256 + r) * DFF + fc) = o;
                    }
                }
        }
        __syncthreads();
    }
};

template <int CTRL> __device__ __forceinline__ float dppf(float v) { return __int_as_float(__builtin_amdgcn_update_dpp(0, __float_as_int(v), CTRL, 0xF, 0xF, false)); }

struct EpiFfnP {
    bf16_t* H; float* ge; float* ue; const float* cw; const float* cb;
    __device__ __forceinline__ void operator()(const AccT& acc, int pm, int pn, int wr, int wc, int fr, int fq) const {
        extern __shared__ __attribute__((aligned(16))) unsigned char smem[];
        float* halo = (float*)(smem + 131072);
#pragma unroll
        for (int ai = 0; ai < 2; ++ai)
#pragma unroll
            for (int n = 0; n < 2; ++n) {
                if (fr == 0) *(f32x4*)(halo + ((ai * 2 + wr) * 2 + 0) * 128 + wc * 32 + fq * 8 + n * 4) = acc[ai][0][0][n];
                if (fr == 15) *(f32x4*)(halo + ((ai * 2 + wr) * 2 + 1) * 128 + wc * 32 + fq * 8 + n * 4) = acc[ai][0][3][n];
            }
        asm volatile("s_waitcnt lgkmcnt(0)" ::: "memory");
        __builtin_amdgcn_s_barrier();
        __builtin_amdgcn_s_barrier();
        asm volatile("" ::: "memory");
        u32x2 hold[2][4];
#pragma unroll
        for (int n = 0; n < 2; ++n) {
            const int gc = wc * 32 + fq * 8 + n * 4;
            const int fc = pn * 128 + gc;
            const f32x4 w0 = *(const f32x4*)(cw + fc), w1 = *(const f32x4*)(cw + DFF + fc), w2 = *(const f32x4*)(cw + 2 * DFF + fc), bb = *(const f32x4*)(cb + fc);
#pragma unroll
            for (int ai = 0; ai < 2; ++ai) {
                f32x4 ha = {0.f, 0.f, 0.f, 0.f}, hb = {0.f, 0.f, 0.f, 0.f};
                if (wr == 1) ha = *(const f32x4*)(halo + ((ai * 2 + 0) * 2 + 1) * 128 + gc);
                else if (ai == 1) ha = *(const f32x4*)(halo + ((0 * 2 + 1) * 2 + 1) * 128 + gc);
                if (wr == 0) hb = *(const f32x4*)(halo + ((ai * 2 + 1) * 2 + 0) * 128 + gc);
                else if (ai == 0) hb = *(const f32x4*)(halo + ((1 * 2 + 0) * 2 + 0) * 128 + gc);
#pragma unroll
                for (int m = 0; m < 4; ++m) {
                    const int r = ai * 128 + wr * 64 + m * 16 + fr;
                    const f32x4 gv = acc[ai][0][m][n], uv = acc[ai][1][m][n];
                    f32x4 gm, gp;
#pragma unroll
                    for (int j = 0; j < 4; ++j) {
                        if (m > 0) { const float t = (fr == 15) ? acc[ai][0][m > 0 ? m - 1 : 0][n][j] : gv[j]; gm[j] = dppf<0x121>(t); }
                        else { gm[j] = dppf<0x121>(gv[j]); if (fr == 0) gm[j] = ha[j]; }
                        if (m < 3) { const float t = (fr == 0) ? acc[ai][0][m < 3 ? m + 1 : 3][n][j] : gv[j]; gp[j] = dppf<0x12F>(t); }
                        else { gp[j] = dppf<0x12F>(gv[j]); if (fr == 15) gp[j] = hb[j]; }
                    }
                    if (r == 0 || r == 255) {
                        *(f32x4*)(ge + ((size_t)pm * 4 + (r == 0 ? 0 : 3)) * DFF + fc) = gv;
                        *(f32x4*)(ue + ((size_t)pm * 2 + (r == 0 ? 0 : 1)) * DFF + fc) = uv;
                    } else {
                        if (r == 1) *(f32x4*)(ge + ((size_t)pm * 4 + 1) * DFF + fc) = gv;
                        if (r == 254) *(f32x4*)(ge + ((size_t)pm * 4 + 2) * DFF + fc) = gv;
                        f32x4 hv;
#pragma unroll
                        for (int j = 0; j < 4; ++j) { const float cv = w0[j] * gm[j] + w1[j] * gv[j] + w2[j] * gp[j] + bb[j]; hv[j] = siluf(cv) * uv[j]; }
                        u32x2 o; o[0] = pk2(hv[0], hv[1]); o[1] = pk2(hv[2], hv[3]);
                        if (n == 0) hold[ai][m] = o;
                        else *(u32x4*)(H + (((size_t)pm * (DFF / 64) + (fc >> 6)) * 256 + r) * 64 + ((fc - 4) & 63)) = (u32x4){hold[ai][m][0], hold[ai][m][1], o[0], o[1]};
                    }
                }
            }
        }
    }
};

__device__ void ffn_edges(const Params& p) {
    bf16_t* H = (bf16_t*)(p.ws + OFF_PROJ);
    const float* ge = (const float*)(p.ws + OFF_GE);
    const float* ue = (const float*)(p.ws + OFF_UE);
    const int total = 320 * 2 * DFF;
    for (int idx = blockIdx.x * NTHR + threadIdx.x; idx < total; idx += gridDim.x * NTHR) {
        const int c = idx % DFF, e = (idx / DFF) & 1, pm = idx / (2 * DFF);
        const int tok = pm * 256 + (e ? 255 : 0);
        int s0, S; tok_seq(tok, s0, S);
        float gm, g0, gp, up;
        if (e == 0) {
            gm = (tok == s0) ? 0.f : ge[((size_t)(pm - 1) * 4 + 3) * DFF + c];
            g0 = ge[((size_t)pm * 4 + 0) * DFF + c]; gp = ge[((size_t)pm * 4 + 1) * DFF + c]; up = ue[((size_t)pm * 2 + 0) * DFF + c];
        } else {
            gm = ge[((size_t)pm * 4 + 2) * DFF + c]; g0 = ge[((size_t)pm * 4 + 3) * DFF + c];
            gp = (tok == s0 + S - 1) ? 0.f : ge[((size_t)(pm + 1) * 4 + 0) * DFF + c]; up = ue[((size_t)pm * 2 + 1) * DFF + c];
        }
        const float cv = p.ffn_conv_w[c] * gm + p.ffn_conv_w[DFF + c] * g0 + p.ffn_conv_w[2 * DFF + c] * gp + p.ffn_conv_b[c];
        H[(((size_t)(tok >> 8) * (DFF / 64) + (c >> 6)) * 256 + (tok & 255)) * 64 + (c & 63)] = f2bf(siluf(cv) * up);
    }
}

__device__ __forceinline__ void qk_norm_rope(const Params& p, int chunk, int h, int t6, int nthr) {
    bf16_t* proj = (bf16_t*)(p.ws + OFF_PROJ);
    bf16_t* kp = (bf16_t*)(p.ws + OFF_HN) + (size_t)T * 512;
    const int tk0 = chunk * 64;
    int s0, S; tok_seq(tk0, s0, S);
    const double INVF[8] = {0.15915494309189535, 0.03086376340470123, 0.005985185712713705, 0.001160663641240061,
                            0.00022507907903927653, 4.364795279280289e-05, 8.464330808241401e-06, 1.6414262627950345e-06};
    constexpr int NIT = 6;
    u32x4 rawv[NIT];
    const float gsub0 = 0.f; (void)gsub0;
#pragma unroll
    for (int it = 0; it < NIT; ++it) {
        const int item = t6 + it * nthr;
        if (item < 2048) {
            const int v = item >> 3, sub = item & 7, tokl = v >> 2, which = (v >> 1) & 1, c = v & 1;
            rawv[it] = *(const u32x4*)(proj + (size_t)(tk0 + tokl) * NPROJ + 2048 + which * 512 + h * 128 + c * 64 + sub * 8);
        }
    }
#pragma unroll
    for (int it = 0; it < NIT; ++it) {
        const int item = t6 + it * nthr;
        if (item < 2048) {
            const int v = item >> 3, sub = item & 7;
            const int tokl = v >> 2, which = (v >> 1) & 1, c = v & 1;
            const int tok = tk0 + tokl;
            bf16_t* ptr = proj + (size_t)tok * NPROJ + 2048 + which * 512 + h * 128 + c * 64 + sub * 8;
            const u32x4 raw = rawv[it];
            float f[8];
#pragma unroll
            for (int e = 0; e < 4; ++e) { f[2 * e] = bflo(raw[e]); f[2 * e + 1] = bfhi(raw[e]); }
            float ss = 0.f;
#pragma unroll
            for (int e = 0; e < 8; ++e) ss += f[e] * f[e];
            ss += __shfl_xor(ss, 1); ss += __shfl_xor(ss, 2); ss += __shfl_xor(ss, 4);
            const float rs = rsqrtf(ss * (1.f / 64.f) + EPS);
            float y[8], pr[8];
#pragma unroll
            for (int e = 0; e < 8; ++e) y[e] = f[e] * rs * p.da_qk_norm_g[which * 64 + sub * 8 + e];
#pragma unroll
            for (int e = 0; e < 8; ++e) pr[e] = __shfl_xor(y[e], 1);
            if (sub < 2) {
                const int pos = tok - s0;
#pragma unroll
                for (int e = 0; e < 8; ++e) {
                    const double rr = (double)pos * INVF[e];
                    const float fr_ = (float)(rr - floor(rr));
                    const float sn = __builtin_amdgcn_sinf(fr_), cs = __builtin_amdgcn_cosf(fr_);
                    y[e] = (sub == 0) ? (y[e] * cs - pr[e] * sn) : (y[e] * cs + pr[e] * sn);
                }
            }
            if (which == 0) {
#pragma unroll
                for (int e = 0; e < 8; ++e) y[e] *= 0.18033688011112042f;
            }
            const u32x4 yo = {pk2(y[0], y[1]), pk2(y[2], y[3]), pk2(y[4], y[5]), pk2(y[6], y[7])};
            if (which == 0) *(u32x4*)ptr = yo;
            else *(u32x4*)(kp + ((size_t)chunk * 4 + h) * 8192 + c * 4096 + tokl * 64 + sub * 8) = yo;
        }
    }
}

__device__ void dn_prep_unit(const Params& p, int chunk, int h) {
    extern __shared__ __attribute__((aligned(16))) unsigned char smem[];
    bf16_t* Kb = (bf16_t*)smem;
    float* Kf = (float*)(smem + 17408);
    float* Vf = (float*)(smem + 50176);
    float* KK = (float*)(smem + 82944);
    float* Am = (float*)(smem + 99584);
    float* gs = (float*)(smem + 132352);
    float* bs = gs + 128;
    float* gcs = bs + 128;
    float* es = gcs + 128;
    int tid_ = threadIdx.x; asm volatile("" : "+v"(tid_));
    const int tid = tid_, lane = tid & 63, wave = tid >> 6, fr = lane & 15, fq = lane >> 4;
    const bf16_t* proj = (const bf16_t*)(p.ws + OFF_PROJ);
    bf16_t* qn = (bf16_t*)(p.ws + OFF_QN);
    bf16_t* kn = (bf16_t*)(p.ws + OFF_KN);
    bf16_t* knt = (bf16_t*)(p.ws + OFF_KNT);
    const float* dab = (const float*)(p.ws + OFF_DAB);
    float* gcg = (float*)(p.ws + OFF_GC);
    bf16_t* ut = (bf16_t*)p.out;
    bf16_t* wrr = (bf16_t*)p.out + (size_t)10240 * 8192;
    const int tk0 = chunk * 64;
    int s0, S; tok_seq(tk0, s0, S);
    bf16_t* VsA = (bf16_t*)(smem + 99584);
#pragma unroll
    for (int it = 0; it < 2; ++it) {
        const int pi = tid + NTHR * it, row = pi >> 4, sub = pi & 15;
        const u32x4 raw = *(const u32x4*)(proj + (size_t)(tk0 + row) * NPROJ + 3072 + h * 128 + sub * 8);
        unsigned* dd = (unsigned*)(VsA + row * 130 + sub * 8);
        dd[0] = raw[0]; dd[1] = raw[1]; dd[2] = raw[2]; dd[3] = raw[3];
    }
    {
        const int rbase = tk0 + wave * 8;
#pragma unroll
        for (int mat = 0; mat < 3; ++mat) {
            const int colb = mat * 512 + h * 128 + 2 * lane;
            unsigned raw[12];
#pragma unroll
            for (int i = 0; i < 12; ++i) { const int t = rbase - 2 + i; raw[i] = (t >= s0 && t < s0 + S) ? *(const unsigned*)(proj + (size_t)t * NPROJ + colb) : 0u; }
            float cw0[5], cw1[5];
#pragma unroll
            for (int j = 0; j < 5; ++j) { cw0[j] = p.dn_conv_w[j * 1536 + colb]; cw1[j] = p.dn_conv_w[j * 1536 + colb + 1]; }
#pragma unroll
            for (int rr = 0; rr < 8; ++rr) {
                float o0 = 0.f, o1 = 0.f;
#pragma unroll
                for (int j = 0; j < 5; ++j) { o0 += cw0[j] * bflo(raw[rr + j]); o1 += cw1[j] * bfhi(raw[rr + j]); }
                o0 = siluf(o0); o1 = siluf(o1);
                const int row = wave * 8 + rr;
                if (mat < 2) {
                    float ss = wave_sum(o0 * o0 + o1 * o1);
                    float sc = rsqrtf(ss + EPS);
                    if (mat == 0) sc *= 0.08838834764831845f;
                    o0 *= sc; o1 *= sc;
                    const unsigned pk = pk2(o0, o1);
                    if (mat == 0) *(unsigned*)(qn + (size_t)(tk0 + row) * 512 + h * 128 + 2 * lane) = pk;
                    else {
                        *(unsigned*)(kn + (size_t)(tk0 + row) * 512 + h * 128 + 2 * lane) = pk;
                        *(unsigned*)(Kb + row * 136 + 2 * lane) = pk;
                        Kf[row * 128 + 2 * lane] = o0; Kf[row * 128 + 2 * lane + 1] = o1;
                    }
                } else { Vf[row * 128 + 2 * lane] = o0; Vf[row * 128 + 2 * lane + 1] = o1; }
            }
        }
        if (lane < 16) {
            const int rr = lane & 7, d = lane >> 3, row = wave * 8 + rr, t = tk0 + row;
            const float da = dab[(size_t)t * 16 + d * 4 + h], db = dab[(size_t)t * 16 + 8 + d * 4 + h];
            const float xx = da + p.dn_dt_bias[d * 4 + h];
            const float sp = fmaxf(xx, 0.f) + log1pf(__expf(-fabsf(xx)));
            gs[d * 64 + row] = -__expf(p.dn_a_log[d * 4 + h]) * sp;
            bs[d * 64 + row] = sigmoidf_(db);
        }
    }
    __syncthreads();
    if (wave < 2) {
        const int d = wave;
        float v = gs[d * 64 + lane];
#pragma unroll
        for (int off = 1; off < 64; off <<= 1) {
            const float tu = __shfl_up(v, off), td = __shfl_down(v, off);
            if (d == 0) { if (lane >= off) v += tu; } else { if (lane + off < 64) v += td; }
        }
        gcs[d * 64 + lane] = v;
        gcg[(size_t)(d * 4 + h) * T + tk0 + lane] = v;
    }
    {
        const int rt = wave & 3, ct0 = (wave >> 2) * 2;
#pragma unroll
        for (int cc = 0; cc < 2; ++cc) {
            const int ct = ct0 + cc;
            f32x4 a4 = {0.f, 0.f, 0.f, 0.f};
#pragma unroll
            for (int ks = 0; ks < 4; ++ks) {
                const bf16x8 a = *(const bf16x8*)(Kb + (rt * 16 + fr) * 136 + ks * 32 + fq * 8);
                const bf16x8 b = *(const bf16x8*)(Kb + (ct * 16 + fr) * 136 + ks * 32 + fq * 8);
                a4 = MFMA16(a, b, a4);
            }
#pragma unroll
            for (int j = 0; j < 4; ++j) KK[(rt * 16 + fq * 4 + j) * 65 + ct * 16 + fr] = a4[j];
        }
    }
    {
        bf16_t* vp = (bf16_t*)(p.ws + OFF_HN);
#pragma unroll
        for (int it = 0; it < 2; ++it) {
            const int item = tid + NTHR * it, dv = item >> 3, piece = item & 7;
            unsigned o[4];
#pragma unroll
            for (int e = 0; e < 4; ++e) { const unsigned lo = VsA[(piece * 8 + 2 * e) * 130 + dv], hi = VsA[(piece * 8 + 2 * e + 1) * 130 + dv]; o[e] = lo | (hi << 16); }
            *(u32x4*)(vp + ((size_t)chunk * 4 + h) * 8192 + dv * 64 + piece * 8) = (u32x4){o[0], o[1], o[2], o[3]};
        }
    }
    {
        const int dk = tid >> 2, piece = tid & 3;
        unsigned o[8];
#pragma unroll
        for (int e = 0; e < 8; ++e) o[e] = pk2(Kf[(piece * 16 + 2 * e) * 128 + dk], Kf[(piece * 16 + 2 * e + 1) * 128 + dk]);
        bf16_t* dst = knt + ((size_t)chunk * 4 + h) * 8192 + dk * 64 + piece * 16;
        *(u32x4*)dst = (u32x4){o[0], o[1], o[2], o[3]};
        *(u32x4*)(dst + 8) = (u32x4){o[4], o[5], o[6], o[7]};
    }
    __syncthreads();
    if (tid < 128) es[tid] = bs[tid] * __expf(gcs[tid]);
    for (int idx = tid; idx < 8192; idx += NTHR) {
        const int d = idx >> 12, ip = (idx >> 6) & 63, jp = idx & 63;
        const int ri = d ? 63 - ip : ip, rj = d ? 63 - jp : jp;
        float val = 0.f;
        if (jp < ip) val = bs[d * 64 + ri] * KK[ri * 65 + rj] * __expf(gcs[d * 64 + ri] - gcs[d * 64 + rj]);
        Am[idx] = val;
    }
    __syncthreads();
#ifndef NO_S5
    bf16_t* Tb0 = (bf16_t*)smem;
    bf16_t* Tb1 = (bf16_t*)(smem + 82944);
    if (__builtin_amdgcn_readfirstlane(wave) < 2) {
        const int d = __builtin_amdgcn_readfirstlane(wave), cp = lane;
        float x[64];
#pragma unroll
        for (int ip = 0; ip < 64; ++ip) x[ip] = (ip == cp) ? 1.f : 0.f;
        const float* Ad = Am + d * 4096;
        asm volatile("" : "+v"(Ad));
        f32x4 cur[4], nxt[4], dg[3];
#pragma unroll
        for (int k = 0; k < 3; ++k) dg[k] = *(const f32x4*)(Ad + (k + 1) * 64);
#pragma unroll
        for (int k = 0; k < 4; ++k) cur[k] = *(const f32x4*)(Ad + (4 + k) * 64);
#pragma unroll
        for (int b = 0; b < 16; ++b) {
            float t0 = 0.f, t1 = 0.f, t2 = 0.f, t3 = 0.f;
            f32x4 dn[3];
#pragma unroll
            for (int q = 0; q < b; ++q) {
                if (q + 1 < b) {
#pragma unroll
                    for (int k = 0; k < 4; ++k) nxt[k] = *(const f32x4*)(Ad + (4 * b + k) * 64 + (q + 1) * 4);
                } else {
#pragma unroll
                    for (int k = 0; k < 3; ++k) dg[k] = *(const f32x4*)(Ad + (4 * b + k + 1) * 64 + b * 4);
                    if (b < 15) {
#pragma unroll
                        for (int k = 0; k < 4; ++k) nxt[k] = *(const f32x4*)(Ad + (4 * (b + 1) + k) * 64);
                    }
                }
                t0 += cur[0][0] * x[4 * q] + cur[0][1] * x[4 * q + 1] + cur[0][2] * x[4 * q + 2] + cur[0][3] * x[4 * q + 3];
                t1 += cur[1][0] * x[4 * q] + cur[1][1] * x[4 * q + 1] + cur[1][2] * x[4 * q + 2] + cur[1][3] * x[4 * q + 3];
                t2 += cur[2][0] * x[4 * q] + cur[2][1] * x[4 * q + 1] + cur[2][2] * x[4 * q + 2] + cur[2][3] * x[4 * q + 3];
                t3 += cur[3][0] * x[4 * q] + cur[3][1] * x[4 * q + 1] + cur[3][2] * x[4 * q + 2] + cur[3][3] * x[4 * q + 3];
                asm volatile("" ::: "memory");
#pragma unroll
                for (int k = 0; k < 4; ++k) cur[k] = nxt[k];
            }
            (void)dn;
            x[4 * b] -= t0;
            x[4 * b + 1] -= t1 + dg[0][0] * x[4 * b];
            x[4 * b + 2] -= t2 + dg[1][0] * x[4 * b] + dg[1][1] * x[4 * b + 1];
            x[4 * b + 3] -= t3 + dg[2][0] * x[4 * b] + dg[2][1] * x[4 * b + 1] + dg[2][2] * x[4 * b + 2];
            asm volatile("" ::: "memory");
        }
        if (d == 0) {
#pragma unroll
            for (int ip = 0; ip < 64; ++ip) Tb0[ip * 72 + cp] = f2bf(x[ip]);
        } else {
#pragma unroll
            for (int ip = 0; ip < 64; ++ip) Tb1[(63 - ip) * 72 + (63 - cp)] = f2bf(x[ip]);
        }
    } else {
        qk_norm_rope(p, chunk, h, tid - 128, NTHR - 128);
    }
    __syncthreads();
    {
        const int d = __builtin_amdgcn_readfirstlane(wave >> 2), mat = __builtin_amdgcn_readfirstlane((wave >> 1) & 1), half = wave & 1;
        const bf16_t* Tb = d ? Tb1 : Tb0;
        const float* R = (mat ? Kf : Vf) + fq * 8 * 128 + half * 64 + fr;
        const float* sc = (mat ? es : bs) + d * 64 + fq * 8;
        asm volatile("" : "+v"(R), "+v"(sc));
        f32x4 acc[4][4];
#pragma unroll
        for (int c4 = 0; c4 < 4; ++c4)
#pragma unroll
            for (int rt = 0; rt < 4; ++rt) acc[c4][rt] = (f32x4){0.f, 0.f, 0.f, 0.f};
#pragma unroll
        for (int ks = 0; ks < 2; ++ks) {
            bf16x8 tf[4];
#pragma unroll
            for (int rt = 0; rt < 4; ++rt) tf[rt] = *(const bf16x8*)(Tb + (rt * 16 + fr) * 72 + ks * 32 + fq * 8);
            const f32x4 s0 = *(const f32x4*)(sc + ks * 32), s1 = *(const f32x4*)(sc + ks * 32 + 4);
#pragma unroll
            for (int c4 = 0; c4 < 4; ++c4) {
                const float* rp = R + ks * 32 * 128 + c4 * 16;
                u32x4 w;
                w[0] = pk2(rp[0] * s0[0], rp[128] * s0[1]); w[1] = pk2(rp[256] * s0[2], rp[384] * s0[3]);
                w[2] = pk2(rp[512] * s1[0], rp[640] * s1[1]); w[3] = pk2(rp[768] * s1[2], rp[896] * s1[3]);
                const bf16x8 rf = __builtin_bit_cast(bf16x8, w);
                if (mat == 0) {
#pragma unroll
                    for (int rt = 0; rt < 4; ++rt) acc[c4][rt] = MFMA16(tf[rt], rf, acc[c4][rt]);
                } else {
#pragma unroll
                    for (int rt = 0; rt < 4; ++rt) acc[c4][rt] = MFMA16(rf, tf[rt], acc[c4][rt]);
                }
                asm volatile("" ::: "memory");
            }
        }
        const size_t uid = ((size_t)d * NCHUNK + chunk) * 4 + h;
        if (mat == 0) {
#pragma unroll
            for (int c4 = 0; c4 < 4; ++c4)
#pragma unroll
                for (int rt = 0; rt < 4; ++rt) {
                    const f32x4 v = acc[c4][rt];
                    u32x2 o; o[0] = pk2(v[0], v[1]); o[1] = pk2(v[2], v[3]);
                    *(u32x2*)(ut + uid * 8192 + (size_t)((half * 4 + c4) * 16 + fr) * 64 + rt * 16 + fq * 4) = o;
                }
        } else {
#pragma unroll
            for (int c4 = 0; c4 < 4; ++c4)
#pragma unroll
                for (int rt = 0; rt < 4; ++rt) {
                    const f32x4 v = acc[c4][rt];
                    u32x2 o; o[0] = pk2(v[0], v[1]); o[1] = pk2(v[2], v[3]);
                    *(u32x2*)(wrr + uid * 8192 + (size_t)(rt * 16 + fr) * 128 + (half * 4 + c4) * 16 + fq * 4) = o;
                }
        }
    }
#endif
    __syncthreads();
}

__device__ void attn_prep_unit(const Params& p, int chunk, int h) {
    extern __shared__ __attribute__((aligned(16))) unsigned char smem[];
    bf16_t* Vs = (bf16_t*)smem;
    const int tid = threadIdx.x;
    bf16_t* proj = (bf16_t*)(p.ws + OFF_PROJ);
    bf16_t* vp = (bf16_t*)(p.ws + OFF_HN);
    bf16_t* kp = (bf16_t*)(p.ws + OFF_HN) + (size_t)T * 512;
    const int tk0 = chunk * 64;
    int s0, S; tok_seq(tk0, s0, S);
    const double INVF[8] = {0.15915494309189535, 0.03086376340470123, 0.005985185712713705, 0.001160663641240061,
                            0.00022507907903927653, 4.364795279280289e-05, 8.464330808241401e-06, 1.6414262627950345e-06};
#pragma unroll
    for (int it = 0; it < 4; ++it) {
        const int item = tid + NTHR * it, v = item >> 3, sub = item & 7;
        const int tokl = v >> 2, which = (v >> 1) & 1, c = v & 1;
        const int tok = tk0 + tokl;
        bf16_t* ptr = proj + (size_t)tok * NPROJ + 2048 + which * 512 + h * 128 + c * 64 + sub * 8;
        const u32x4 raw = *(const u32x4*)ptr;
        float f[8];
#pragma unroll
        for (int e = 0; e < 4; ++e) { f[2 * e] = bflo(raw[e]); f[2 * e + 1] = bfhi(raw[e]); }
        float ss = 0.f;
#pragma unroll
        for (int e = 0; e < 8; ++e) ss += f[e] * f[e];
        ss += __shfl_xor(ss, 1); ss += __shfl_xor(ss, 2); ss += __shfl_xor(ss, 4);
        const float rs = rsqrtf(ss * (1.f / 64.f) + EPS);
        float y[8], pr[8];
#pragma unroll
        for (int e = 0; e < 8; ++e) y[e] = f[e] * rs * p.da_qk_norm_g[which * 64 + sub * 8 + e];
#pragma unroll
        for (int e = 0; e < 8; ++e) pr[e] = __shfl_xor(y[e], 1);
        if (sub < 2) {
            const int pos = tok - s0;
#pragma unroll
            for (int e = 0; e < 8; ++e) {
                const double rr = (double)pos * INVF[e];
                const float fr_ = (float)(rr - floor(rr));
                const float sn = __builtin_amdgcn_sinf(fr_), cs = __builtin_amdgcn_cosf(fr_);
                y[e] = (sub == 0) ? (y[e] * cs - pr[e] * sn) : (y[e] * cs + pr[e] * sn);
            }
        }
        if (which == 0) {
#pragma unroll
            for (int e = 0; e < 8; ++e) y[e] *= 0.18033688011112042f;
        }
        const u32x4 yo = {pk2(y[0], y[1]), pk2(y[2], y[3]), pk2(y[4], y[5]), pk2(y[6], y[7])};
        if (which == 0) *(u32x4*)ptr = yo;
        else *(u32x4*)(kp + ((size_t)chunk * 4 + h) * 8192 + c * 4096 + tokl * 64 + sub * 8) = yo;
    }
#pragma unroll
    for (int it = 0; it < 2; ++it) {
        const int pi = tid + NTHR * it, row = pi >> 4, sub = pi & 15;
        const u32x4 raw = *(const u32x4*)(proj + (size_t)(tk0 + row) * NPROJ + 3072 + h * 128 + sub * 8);
        unsigned* d = (unsigned*)(Vs + row * 130 + sub * 8);
        d[0] = raw[0]; d[1] = raw[1]; d[2] = raw[2]; d[3] = raw[3];
    }
    __syncthreads();
#pragma unroll
    for (int it = 0; it < 2; ++it) {
        const int item = tid + NTHR * it, dv = item >> 3, piece = item & 7;
        unsigned o[4];
#pragma unroll
        for (int e = 0; e < 4; ++e) { const unsigned lo = Vs[(piece * 8 + 2 * e) * 130 + dv], hi = Vs[(piece * 8 + 2 * e + 1) * 130 + dv]; o[e] = lo | (hi << 16); }
        *(u32x4*)(vp + ((size_t)chunk * 4 + h) * 8192 + dv * 64 + piece * 8) = (u32x4){o[0], o[1], o[2], o[3]};
    }
    __syncthreads();
}

__device__ void dn_scan_unit(const Params& p, int u) {
    extern __shared__ __attribute__((aligned(16))) unsigned char smem[];
    bf16_t* Kb = (bf16_t*)smem;
    bf16_t* Vt = (bf16_t*)smem;
    bf16_t* Qb = (bf16_t*)(smem + 18432);
    bf16_t* QDb = (bf16_t*)(smem + 35840);
    bf16_t* KDt = (bf16_t*)(smem + 53248);
    bf16_t* Wb = (bf16_t*)(smem + 71680);
    bf16_t* St = (bf16_t*)(smem + 89088);
    bf16_t* QKm = (bf16_t*)(smem + 123904);
    float* gcs = (float*)(smem + 133120);
    const int tid = threadIdx.x, lane = tid & 63, wave = tid >> 6, fr = lane & 15, fq = lane >> 4;
    int sq, h, d;
    if (u < 128) { sq = 8 + (u >> 3); h = (u >> 1) & 3; d = u & 1; } else { const int u2 = u - 128; sq = u2 >> 3; h = (u2 >> 1) & 3; d = u2 & 1; }
    const int S = sq < 8 ? 2048 : 4096;
    const int s0 = sq < 8 ? sq * 2048 : TP + (sq - 8) * 4096;
    const int N = S / 64;
    const bf16_t* qn = (const bf16_t*)(p.ws + OFF_QN);
    const bf16_t* kn = (const bf16_t*)(p.ws + OFF_KN);
    const bf16_t* knt = (const bf16_t*)(p.ws + OFF_KNT);
    const float* gcg = (const float*)(p.ws + OFF_GC) + (size_t)(d * 4 + h) * T;
    const bf16_t* ut = (const bf16_t*)p.out;
    const bf16_t* wrr = (const bf16_t*)p.out + (size_t)10240 * 8192;
    bf16_t* proj = (bf16_t*)(p.ws + OFF_PROJ);
    f32x4 sacc[8];
#pragma unroll
    for (int i = 0; i < 8; ++i) sacc[i] = (f32x4){0.f, 0.f, 0.f, 0.f};
    for (int i = tid; i < 128 * 136 / 2; i += NTHR) ((unsigned*)St)[i] = 0u;
    __syncthreads();
    const int rt = wave & 3, cg4 = wave >> 2;
    u32x4 pkq[2], pqq[2], pww[2], pkk[2]; f32x4 pg0[2], pg1[2]; float pgr[2], pgcl, pgcs = 0.f; u32x2 puv[4];
#define SCAN_LOAD(NP) do { const int cis_ = d ? N - 1 - (NP) : (NP); const int tk_ = s0 + cis_ * 64; const int cg_ = tk_ >> 6; \
        const size_t uid_ = ((size_t)d * NCHUNK + cg_) * 4 + h; \
        pgcl = gcg[tk_ + (d ? 0 : 63)]; \
        _Pragma("unroll") for (int it = 0; it < 2; ++it) { const int pi = tid + NTHR * it, row = pi >> 4, sub = pi & 15; \
            pkq[it] = *(const u32x4*)(kn + (size_t)(tk_ + row) * 512 + h * 128 + sub * 8); \
            pqq[it] = *(const u32x4*)(qn + (size_t)(tk_ + row) * 512 + h * 128 + sub * 8); \
            pww[it] = *(const u32x4*)(wrr + uid_ * 8192 + row * 128 + sub * 8); \
            pgr[it] = gcg[tk_ + row]; \
            const int dk = pi >> 3, piece = pi & 7; \
            pkk[it] = *(const u32x4*)(knt + ((size_t)cg_ * 4 + h) * 8192 + dk * 64 + piece * 8); \
            pg0[it] = *(const f32x4*)(gcg + tk_ + piece * 8); pg1[it] = *(const f32x4*)(gcg + tk_ + piece * 8 + 4); } \
        if (tid < 64) pgcs = gcg[tk_ + tid]; \
        _Pragma("unroll") for (int c4 = 0; c4 < 4; ++c4) { const int ct = (wave >> 2) * 4 + c4; puv[c4] = *(const u32x2*)(ut + uid_ * 8192 + (size_t)(ct * 16 + fr) * 64 + (wave & 3) * 16 + fq * 4); } \
    } while (0)
    SCAN_LOAD(0);
    for (int np = 0; np < N; ++np) {
        const int cis = d ? N - 1 - np : np;
        const int tk0 = s0 + cis * 64;
        const float gcl = pgcl;
#pragma unroll
        for (int it = 0; it < 2; ++it) {
            const int pi = tid + NTHR * it, row = pi >> 4, sub = pi & 15;
            const float eg = __expf(pgr[it]);
            *(u32x4*)(Kb + row * 136 + sub * 8) = pkq[it];
            *(u32x4*)(Qb + row * 136 + sub * 8) = pqq[it];
            *(u32x4*)(Wb + row * 136 + sub * 8) = pww[it];
            u32x4 qd;
#pragma unroll
            for (int e = 0; e < 4; ++e) qd[e] = pk2(bflo(pqq[it][e]) * eg, bfhi(pqq[it][e]) * eg);
            *(u32x4*)(QDb + row * 136 + sub * 8) = qd;
            const int dk = pi >> 3, piece = pi & 7;
            const u32x4 kk = pkk[it]; const f32x4 g0 = pg0[it], g1 = pg1[it];
            u32x4 o;
            o[0] = pk2(bflo(kk[0]) * __expf(gcl - g0[0]), bfhi(kk[0]) * __expf(gcl - g0[1]));
            o[1] = pk2(bflo(kk[1]) * __expf(gcl - g0[2]), bfhi(kk[1]) * __expf(gcl - g0[3]));
            o[2] = pk2(bflo(kk[2]) * __expf(gcl - g1[0]), bfhi(kk[2]) * __expf(gcl - g1[1]));
            o[3] = pk2(bflo(kk[3]) * __expf(gcl - g1[2]), bfhi(kk[3]) * __expf(gcl - g1[3]));
            *(u32x4*)(KDt + dk * 72 + piece * 8) = o;
        }
        if (tid < 64) gcs[tid] = pgcs;
        u32x2 uv[4];
#pragma unroll
        for (int c4 = 0; c4 < 4; ++c4) uv[c4] = puv[c4];
        __syncthreads();
        if (np + 1 < N) SCAN_LOAD(np + 1);
#pragma unroll
        for (int cc = 0; cc < 2; ++cc) {
            const int ct = cg4 * 2 + cc;
            f32x4 a4 = {0.f, 0.f, 0.f, 0.f};
#pragma unroll
            for (int ks = 0; ks < 4; ++ks) {
                const bf16x8 a = *(const bf16x8*)(Qb + (rt * 16 + fr) * 136 + ks * 32 + fq * 8);
                const bf16x8 b = *(const bf16x8*)(Kb + (ct * 16 + fr) * 136 + ks * 32 + fq * 8);
                a4 = MFMA16(a, b, a4);
            }
            const int jj = ct * 16 + fr;
            const float gj = gcs[jj];
#pragma unroll
            for (int j = 0; j < 4; ++j) {
                const int i = rt * 16 + fq * 4 + j;
                const bool keep = d ? (jj >= i) : (jj <= i);
                const float val = keep ? a4[j] * __expf(gcs[i] - gj) : 0.f;
                QKm[i * 72 + jj] = f2bf(val);
            }
        }
        f32x4 ws4[4], qs4[4];
#pragma unroll
        for (int c4 = 0; c4 < 4; ++c4) { ws4[c4] = (f32x4){0.f, 0.f, 0.f, 0.f}; qs4[c4] = (f32x4){0.f, 0.f, 0.f, 0.f}; }
#pragma unroll
        for (int ks = 0; ks < 4; ++ks) {
            const bf16x8 aw = *(const bf16x8*)(Wb + (rt * 16 + fr) * 136 + ks * 32 + fq * 8);
            const bf16x8 aq = *(const bf16x8*)(QDb + (rt * 16 + fr) * 136 + ks * 32 + fq * 8);
#pragma unroll
            for (int c4 = 0; c4 < 4; ++c4) {
                const int ct = cg4 * 4 + c4;
                const bf16x8 b = *(const bf16x8*)(St + (ct * 16 + fr) * 136 + ks * 32 + fq * 8);
                ws4[c4] = MFMA16(aw, b, ws4[c4]);
                qs4[c4] = MFMA16(b, aq, qs4[c4]);
            }
        }
        __syncthreads();
#pragma unroll
        for (int c4 = 0; c4 < 4; ++c4) {
            const int ct = cg4 * 4 + c4;
            const float v0 = bflo(uv[c4][0]) - ws4[c4][0], v1 = bfhi(uv[c4][0]) - ws4[c4][1], v2 = bflo(uv[c4][1]) - ws4[c4][2], v3 = bfhi(uv[c4][1]) - ws4[c4][3];
            u32x2 o; o[0] = pk2(v0, v1); o[1] = pk2(v2, v3);
            *(u32x2*)(Vt + (ct * 16 + fr) * 72 + rt * 16 + fq * 4) = o;
        }
        __syncthreads();
#pragma unroll
        for (int ks = 0; ks < 2; ++ks) {
            const bf16x8 a = *(const bf16x8*)(QKm + (rt * 16 + fr) * 72 + ks * 32 + fq * 8);
#pragma unroll
            for (int c4 = 0; c4 < 4; ++c4) {
                const int ct = cg4 * 4 + c4;
                const bf16x8 b = *(const bf16x8*)(Vt + (ct * 16 + fr) * 72 + ks * 32 + fq * 8);
                qs4[c4] = MFMA16(b, a, qs4[c4]);
            }
        }
#pragma unroll
        for (int c4 = 0; c4 < 4; ++c4) {
            const int ct = cg4 * 4 + c4;
            { u32x2 o; o[0] = pk2(qs4[c4][0], qs4[c4][1]); o[1] = pk2(qs4[c4][2], qs4[c4][3]);
              *(u32x2*)(proj + (size_t)(tk0 + rt * 16 + fr) * NPROJ + d * 512 + h * 128 + ct * 16 + fq * 4) = o; }
        }
        const float gl = __expf(gcl);
#pragma unroll
        for (int c8 = 0; c8 < 8; ++c8) sacc[c8] = sacc[c8] * gl;
#pragma unroll
        for (int ks = 0; ks < 2; ++ks) {
            const bf16x8 a = *(const bf16x8*)(KDt + (wave * 16 + fr) * 72 + ks * 32 + fq * 8);
#pragma unroll
            for (int c8 = 0; c8 < 8; ++c8) {
                const bf16x8 b = *(const bf16x8*)(Vt + (c8 * 16 + fr) * 72 + ks * 32 + fq * 8);
                sacc[c8] = MFMA16(a, b, sacc[c8]);
            }
        }
#pragma unroll
        for (int c8 = 0; c8 < 8; ++c8) {
            u32x2 o; o[0] = pk2(sacc[c8][0], sacc[c8][1]); o[1] = pk2(sacc[c8][2], sacc[c8][3]);
            *(u32x2*)(St + (c8 * 16 + fr) * 136 + wave * 16 + fq * 4) = o;
        }
        __syncthreads();
    }
}

template <int ORD>
__device__ __forceinline__ void attn_unit(const Params& p, int a, float lam, float negC) {
    extern __shared__ __attribute__((aligned(16))) unsigned char smem[];
    int tid_ = threadIdx.x; asm volatile("" : "+v"(tid_));
    const int tid = tid_, lane = tid & 63, wave = tid >> 6, fr = lane & 15, fq = lane >> 4;
    int sq, h, qb;
    if (a < 2048) { sq = 8 + (a >> 7); const int rem = a & 127; h = rem >> 5; qb = rem & 31; }
    else { const int a2 = a - 2048; sq = a2 >> 6; const int rem = a2 & 63; h = rem >> 4; qb = rem & 15; }
    const int S = sq < 8 ? 2048 : 4096;
    const int s0 = sq < 8 ? sq * 2048 : TP + (sq - 8) * 4096;
    const int q0 = s0 + qb * 128, nt = S / 64;
    const int c = wave >> 2, wq = wave & 3;
    bf16_t* proj = (bf16_t*)(p.ws + OFF_PROJ);
    const bf16_t* vp = (const bf16_t*)(p.ws + OFF_HN) + ((size_t)(s0 >> 6) * 4 + h) * 8192;
    const bf16_t* kp = (const bf16_t*)(p.ws + OFF_HN) + (size_t)T * 512 + ((size_t)(s0 >> 6) * 4 + h) * 8192;
    bf16x8 qf[2][2];
#pragma unroll
    for (int rt = 0; rt < 2; ++rt)
#pragma unroll
        for (int ks = 0; ks < 2; ++ks)
            qf[rt][ks] = *(const bf16x8*)(proj + (size_t)(q0 + wq * 32 + rt * 16 + fr) * NPROJ + 2048 + h * 128 + c * 64 + ks * 32 + fq * 8);
    f32x4 ot[8][2];
#pragma unroll
    for (int dt = 0; dt < 8; ++dt) { ot[dt][0] = (f32x4){0.f, 0.f, 0.f, 0.f}; ot[dt][1] = (f32x4){0.f, 0.f, 0.f, 0.f}; }
    float lrow[2] = {0.f, 0.f};
    u32x4 kreg[2], vreg[2];
    const int kkey_ = tid >> 3;
    const int kperm = (((kkey_ >> 5) * 2 + ((kkey_ >> 2) & 1)) * 16) + ((kkey_ >> 3) & 3) * 4 + (kkey_ & 3);
#define ATT_LOAD(t) do { const bf16_t* kb_ = kp + (size_t)(t) * (4 * 8192); const bf16_t* vb_ = vp + (size_t)(t) * (4 * 8192); \
        kreg[0] = *(const u32x4*)(kb_ + tid * 8); kreg[1] = *(const u32x4*)(kb_ + 4096 + tid * 8); \
        vreg[0] = *(const u32x4*)(vb_ + tid * 8); vreg[1] = *(const u32x4*)(vb_ + 4096 + tid * 8); } while (0)
#define ATT_STORE(buf) do { bf16_t* Ks_ = (bf16_t*)(smem + (buf) * 36864); bf16_t* Vs_ = Ks_ + 9216; _Pragma("unroll") for (int it = 0; it < 2; ++it) { \
        *(u32x4*)(Ks_ + (it * 64 + kperm) * 72 + (tid & 7) * 8) = kreg[it]; \
        *(u32x4*)(Vs_ + ((tid >> 3) + it * 64) * 72 + (tid & 7) * 8) = vreg[it]; } } while (0)
    if (__builtin_amdgcn_readfirstlane(threadIdx.x) >= 256) __builtin_amdgcn_s_setprio(1);
    f32x4 st[4][2];
    bf16x8 pbp[2][2];
    {
        const u32x4 z4 = {0u, 0u, 0u, 0u};
        pbp[0][0] = pbp[0][1] = pbp[1][0] = pbp[1][1] = __builtin_bit_cast(bf16x8, z4);
        ATT_LOAD(0);
        ATT_STORE(0);
        ATT_LOAD(1);
        ATT_STORE(1);
        __syncthreads();
        bf16_t* Vz = (bf16_t*)(smem + 36864) + 9216;
        for (int i = tid; i < 9216 / 8; i += NTHR) *(u32x4*)(Vz + i * 8) = z4;
        const bf16_t* Ks = (const bf16_t*)smem;
#pragma unroll
        for (int kt = 0; kt < 4; ++kt) {
            st[kt][0] = (f32x4){negC, negC, negC, negC}; st[kt][1] = (f32x4){negC, negC, negC, negC};
#pragma unroll
            for (int ks = 0; ks < 2; ++ks) {
                const bf16x8 ka = *(const bf16x8*)(Ks + (c * 64 + kt * 16 + fr) * 72 + ks * 32 + fq * 8);
                st[kt][0] = MFMA16(ka, qf[0][ks], st[kt][0]);
                st[kt][1] = MFMA16(ka, qf[1][ks], st[kt][1]);
            }
        }
        __syncthreads();
    }
    for (int t = 0; t < nt; ++t) {
        { const int tk = (t + 2 < nt) ? t + 2 : nt - 1;
          const bf16_t* kb_ = kp + (size_t)tk * (4 * 8192); const bf16_t* vb_ = vp + (size_t)t * (4 * 8192);
          kreg[0] = *(const u32x4*)(kb_ + tid * 8); kreg[1] = *(const u32x4*)(kb_ + 4096 + tid * 8);
          vreg[0] = *(const u32x4*)(vb_ + tid * 8); vreg[1] = *(const u32x4*)(vb_ + 4096 + tid * 8); }
        const bf16_t* Ks = (const bf16_t*)(smem + ((t + 1) & 1) * 36864);
        const bf16_t* Vs = Ks + 9216;
        u32x4 pbn[2][2];
#pragma unroll
        for (int kt = 0; kt < 4; ++kt) {
            bf16x8 ka[2], va[2][2];
#pragma unroll
            for (int ks = 0; ks < 2; ++ks) ka[ks] = *(const bf16x8*)(Ks + (c * 64 + kt * 16 + fr) * 72 + ks * 32 + fq * 8);
#pragma unroll
            for (int dd = 0; dd < 2; ++dd)
#pragma unroll
                for (int s = 0; s < 2; ++s) {
                    const int dt = kt * 2 + dd;
                    va[dd][s] = *(const bf16x8*)(Vs + (dt * 16 + fr) * 72 + s * 32 + fq * 8);
                }
            if (ORD == 1) {
#pragma unroll
                for (int dd = 0; dd < 2; ++dd) {
                    const int dt = kt * 2 + dd;
#pragma unroll
                    for (int s = 0; s < 2; ++s) {
                        ot[dt][0] = MFMA16(va[dd][s], pbp[0][s], ot[dt][0]);
                        ot[dt][1] = MFMA16(va[dd][s], pbp[1][s], ot[dt][1]);
                    }
                }
                __builtin_amdgcn_sched_barrier(0);
            }
#pragma unroll
            for (int rt = 0; rt < 2; ++rt) {
                float pv[4];
#pragma unroll
                for (int j = 0; j < 4; ++j) pv[j] = __builtin_amdgcn_exp2f(st[kt][rt][j]);
                lrow[rt] += (pv[0] + pv[1]) + (pv[2] + pv[3]);
                pbn[rt][kt >> 1][(kt & 1) * 2] = pk2(pv[0], pv[1]);
                pbn[rt][kt >> 1][(kt & 1) * 2 + 1] = pk2(pv[2], pv[3]);
            }
            st[kt][0] = (f32x4){negC, negC, negC, negC}; st[kt][1] = (f32x4){negC, negC, negC, negC};
#pragma unroll
            for (int ks = 0; ks < 2; ++ks) {
                st[kt][0] = MFMA16(ka[ks], qf[0][ks], st[kt][0]);
                st[kt][1] = MFMA16(ka[ks], qf[1][ks], st[kt][1]);
            }
            if (ORD == 0) {
#pragma unroll
                for (int dd = 0; dd < 2; ++dd) {
                    const int dt = kt * 2 + dd;
#pragma unroll
                    for (int s = 0; s < 2; ++s) {
                        ot[dt][0] = MFMA16(va[dd][s], pbp[0][s], ot[dt][0]);
                        ot[dt][1] = MFMA16(va[dd][s], pbp[1][s], ot[dt][1]);
                    }
                }
            }
            __builtin_amdgcn_sched_barrier(0);
        }
        pbp[0][0] = __builtin_bit_cast(bf16x8, pbn[0][0]); pbp[0][1] = __builtin_bit_cast(bf16x8, pbn[0][1]);
        pbp[1][0] = __builtin_bit_cast(bf16x8, pbn[1][0]); pbp[1][1] = __builtin_bit_cast(bf16x8, pbn[1][1]);
        ATT_STORE(t & 1);
        __syncthreads();
    }
    {
        const bf16_t* Vs = (const bf16_t*)(smem + ((nt - 1) & 1) * 36864) + 9216;
#pragma unroll
        for (int dt = 0; dt < 8; ++dt)
#pragma unroll
            for (int s = 0; s < 2; ++s) {
                const bf16x8 va = *(const bf16x8*)(Vs + (dt * 16 + fr) * 72 + s * 32 + fq * 8);
                ot[dt][0] = MFMA16(va, pbp[0][s], ot[dt][0]);
                ot[dt][1] = MFMA16(va, pbp[1][s], ot[dt][1]);
            }
        __syncthreads();
    }
#undef ATT_LOAD
#undef ATT_STORE
    __builtin_amdgcn_s_setprio(0);
    float inv[2];
#pragma unroll
    for (int rt = 0; rt < 2; ++rt) { float l = lrow[rt]; l += __shfl_xor(l, 16); l += __shfl_xor(l, 32); inv[rt] = 1.f / l; }
    float* Ox = (float*)smem;
    if (c == 1) {
#pragma unroll
        for (int rt = 0; rt < 2; ++rt)
#pragma unroll
            for (int dt = 0; dt < 8; ++dt) *(f32x4*)(Ox + (wq * 32 + rt * 16 + fr) * 132 + dt * 16 + fq * 4) = ot[dt][rt] * inv[rt];
    }
    __syncthreads();
    if (c == 0) {
#pragma unroll
        for (int rt = 0; rt < 2; ++rt) {
            float ss = 0.f;
#pragma unroll
            for (int dt = 0; dt < 8; ++dt) {
                const f32x4 o2 = *(const f32x4*)(Ox + (wq * 32 + rt * 16 + fr) * 132 + dt * 16 + fq * 4);
                ot[dt][rt] = ot[dt][rt] * inv[rt] - lam * o2;
                ss += ot[dt][rt][0] * ot[dt][rt][0] + ot[dt][rt][1] * ot[dt][rt][1] + ot[dt][rt][2] * ot[dt][rt][2] + ot[dt][rt][3] * ot[dt][rt][3];
            }
            ss += __shfl_xor(ss, 16); ss += __shfl_xor(ss, 32);
            const float rs = rsqrtf(ss * (1.f / 128.f) + EPS) * 0.8f;
            const int row = q0 + wq * 32 + rt * 16 + fr;
#pragma unroll
            for (int dt = 0; dt < 8; ++dt) {
                const f32x4 g = *(const f32x4*)(p.da_subln_g + dt * 16 + fq * 4);
                const f32x4 v = ot[dt][rt] * rs * g;
                u32x2 o; o[0] = pk2(v[0], v[1]); o[1] = pk2(v[2], v[3]);
                *(u32x2*)(proj + (size_t)row * NPROJ + 2048 + h * 128 + dt * 16 + fq * 4) = o;
            }
        }
    }
    __syncthreads();
}

__device__ void dn_combine(const Params& p) {
    bf16_t* proj = (bf16_t*)(p.ws + OFF_PROJ);
    const int tid = threadIdx.x, lane = tid & 63, wave = tid >> 6;
    float gn[8];
#pragma unroll
    for (int e = 0; e < 8; ++e) gn[e] = p.dn_norm_g[(lane * 8 + e) & 127];
    for (int t0 = (blockIdx.x * 8 + wave) * 4; t0 < T; t0 += gridDim.x * 8 * 4) {
        u32x4 a[4], b[4], z[4];
#pragma unroll
        for (int k = 0; k < 4; ++k) { const bf16_t* row = proj + (size_t)(t0 + k) * NPROJ; a[k] = *(const u32x4*)(row + lane * 8); b[k] = *(const u32x4*)(row + 512 + lane * 8); z[k] = *(const u32x4*)(row + 1536 + lane * 8); }
#pragma unroll
        for (int k = 0; k < 4; ++k) {
            float s[8], zz[8];
#pragma unroll
            for (int e = 0; e < 4; ++e) { s[2 * e] = bflo(a[k][e]) + bflo(b[k][e]); s[2 * e + 1] = bfhi(a[k][e]) + bfhi(b[k][e]); zz[2 * e] = bflo(z[k][e]); zz[2 * e + 1] = bfhi(z[k][e]); }
            float ss = 0.f;
#pragma unroll
            for (int e = 0; e < 8; ++e) ss += s[e] * s[e];
            ss += __shfl_xor(ss, 1); ss += __shfl_xor(ss, 2); ss += __shfl_xor(ss, 4); ss += __shfl_xor(ss, 8);
            const float rs = rsqrtf(ss * (1.f / 128.f) + EPS);
            float y[8];
#pragma unroll
            for (int e = 0; e < 8; ++e) y[e] = s[e] * rs * gn[e] * siluf(zz[e]);
            *(u32x4*)(proj + (size_t)(t0 + k) * NPROJ + 1536 + lane * 8) = (u32x4){pk2(y[0], y[1]), pk2(y[2], y[3]), pk2(y[4], y[5]), pk2(y[6], y[7])};
        }
    }
}

__device__ void pe_convert(const Params& p) {
    bf16_t* pe = (bf16_t*)(p.ws + OFF_PE);
    const size_t total = (size_t)T * PLE / 4, stride = (size_t)gridDim.x * NTHR;
    for (size_t i0 = (size_t)blockIdx.x * NTHR + threadIdx.x; i0 < total; i0 += 4 * stride) {
        f32x4 v[4];
#pragma unroll
        for (int k = 0; k < 4; ++k) { const size_t i = i0 + k * stride; if (i < total) v[k] = *(const f32x4*)(prow(p, (int)(i >> 6)) + (int)(i & 63) * 4); }
#pragma unroll
        for (int k = 0; k < 4; ++k) { const size_t i = i0 + k * stride; if (i < total) { u32x2 o; o[0] = pk2(v[k][0], v[k][1]); o[1] = pk2(v[k][2], v[k][3]); *(u32x2*)(pe + (i >> 6) * PLE + (i & 63) * 4) = o; } }
    }
}

#ifndef DUMP_MODE
#define DUMP_MODE 6
#endif
__device__ void dump_phase(const Params& p) {
    const bf16_t* proj = (const bf16_t*)(p.ws + OFF_PROJ);
    const bf16_t* hn = (const bf16_t*)(p.ws + OFF_HN);
    const bf16_t* qk = (const bf16_t*)(p.ws + OFF_QK);
    const float* dab = (const float*)(p.ws + OFF_DAB);
    const float* gc = (const float*)(p.ws + OFF_GC);
    const size_t total = (size_t)T * DM;
    for (size_t i = (size_t)blockIdx.x * NTHR + threadIdx.x; i < total; i += (size_t)gridDim.x * NTHR) {
        const size_t t = i >> 10; const int c = (int)(i & 1023);
        float v = 1.f;
        if (DUMP_MODE == 1) v += bf2f(hn[i]) + dab[t * 16 + (c & 15)];
        if (DUMP_MODE == 2 || DUMP_MODE == 3) { v += bf2f(proj[t * NPROJ + c]) + bf2f(proj[t * NPROJ + 1024 + c]) + bf2f(proj[t * NPROJ + 2048 + c]); if (c < 512) v += bf2f(proj[t * NPROJ + 3072 + c]); }
        if (DUMP_MODE == 3) {
            v += bf2f(qk[i]);
            if (c < 512) v += bf2f(qk[total + t * 512 + c]);
            if (c < 512) v += bf2f(hn[t * 512 + c]);
            if (c < 8) v += gc[(size_t)c * T + t];
            const unsigned w = ((const unsigned*)p.out)[i];
            v += bflo(w) + bfhi(w);
        }
        if (DUMP_MODE == 4) { v += 100.f * bf2f(proj[t * NPROJ + c]); }
        if (DUMP_MODE == 5) { v += 100.f * bf2f(qk[i]); if (c < 512) v += 100.f * bf2f(qk[total + t * 512 + c]) + bf2f(hn[t * 512 + c]); if (c < 8) v += gc[(size_t)c * T + t]; v += bf2f(proj[t * NPROJ + 2048 + c]); }
        if (DUMP_MODE == 6) { const unsigned w = ((const unsigned*)p.out)[i]; v += fminf(fmaxf(bflo(w) + bfhi(w), -8.f), 8.f); }
        p.out[i] = v;
    }
}

#define XB_TMO      128
#define XB_XCNT(j)  (256  + 64 * (j))
#define XB_XSUB(j)  (1280 + 64 * (j))
#define XB_XGEN(j)  (2304 + 64 * (j))
#define XB_TOP      3328
#define XB_TOPGEN   3392
#define XCD_BAR_WORDS 3456
#define XB_SPIN_CAP (1u << 18)

__device__ __forceinline__ unsigned xb_ld(unsigned* p)              { return __hip_atomic_load(p, __ATOMIC_RELAXED, __HIP_MEMORY_SCOPE_AGENT); }
__device__ __forceinline__ unsigned xb_add(unsigned* p, unsigned v) { return __hip_atomic_fetch_add(p, v, __ATOMIC_RELAXED, __HIP_MEMORY_SCOPE_AGENT); }
__device__ __forceinline__ unsigned xb_xcc_id() { return (unsigned)__builtin_amdgcn_s_getreg((3 << 11) | 20) & 0xFu; }
#define XB_SPIN(cond, bar) do { unsigned _sp = 0; while (cond) { __builtin_amdgcn_s_sleep(1); \
    if ((++_sp & 255u) == 0u) { if (xb_ld(&(bar)[XB_TMO])) break; if (_sp > XB_SPIN_CAP) { atomicAdd(&(bar)[XB_TMO], 1u); break; } } } } while (0)

struct XcdBarrier {
    unsigned* bar; unsigned x;
    volatile LAS unsigned* st;
};

__device__ __forceinline__ XcdBarrier xcd_barrier_post(unsigned* bar, volatile LAS unsigned* st) {
    XcdBarrier b; b.bar = bar; b.x = xb_xcc_id(); b.st = st;
    if (threadIdx.x == 0) (void)xb_add(&bar[XB_XCNT(b.x)], 1u);
    return b;
}
__device__ __forceinline__ void xcd_barrier_complete(unsigned* bar, unsigned x, unsigned& nloc, unsigned& nx) {
    const unsigned G = gridDim.x * gridDim.y * gridDim.z;
    unsigned sum, cnt, mine, sp = 0u;
    for (;;) {
        sum = 0u; cnt = 0u; mine = 0u;
#pragma unroll
        for (unsigned j = 0; j < 16; ++j) { const unsigned c = xb_ld(&bar[XB_XCNT(j)]); sum += c; cnt += (c > 0u) ? 1u : 0u; mine = (j == x) ? c : mine; }
        if (sum == G) break;
        __builtin_amdgcn_s_sleep(1);
        if ((++sp & 255u) == 0u) { if (xb_ld(&bar[XB_TMO])) break; if (sp > XB_SPIN_CAP) { atomicAdd(&bar[XB_TMO], 1u); break; } }
    }
    nloc = mine > 0u ? mine : 1u; nx = cnt > 0u ? cnt : 1u;
}

__device__ __forceinline__ void xcd_barrier(const XcdBarrier& b) {
    asm volatile("s_waitcnt vmcnt(0)" ::: "memory");
    __syncthreads();
    if (threadIdx.x == 0) {
        unsigned* bar = b.bar;
        __builtin_amdgcn_s_waitcnt(0);
        unsigned nloc = b.st[0], nx = b.st[1];
        if (nloc == 0u) { xcd_barrier_complete(bar, b.x, nloc, nx); b.st[0] = nloc; b.st[1] = nx; }
        const unsigned old = xb_add(&bar[XB_XSUB(b.x)], 1u);
        const unsigned gen = old / nloc;
        if (old + 1u == (gen + 1u) * nloc) {
            __builtin_amdgcn_fence(__ATOMIC_RELEASE, "agent");
            asm volatile("s_waitcnt vmcnt(0)" ::: "memory");
            const unsigned og = xb_add(&bar[XB_TOP], 1u);
            const unsigned tg = og / nx;
            if (og + 1u == (tg + 1u) * nx) xb_add(&bar[XB_TOPGEN], 1u);
            else XB_SPIN(xb_ld(&bar[XB_TOPGEN]) == tg, bar);
            __builtin_amdgcn_fence(__ATOMIC_ACQUIRE, "agent");
            xb_add(&bar[XB_XGEN(b.x)], 1u);
            asm volatile("s_waitcnt vmcnt(0)" ::: "memory");
        } else {
            XB_SPIN(xb_ld(&bar[XB_XGEN(b.x)]) == gen, bar);
            __builtin_amdgcn_fence(__ATOMIC_ACQUIRE, "agent");
            asm volatile("s_waitcnt vmcnt(0)" ::: "memory");
        }
    }
    __syncthreads();
}


__global__ void __launch_bounds__(NTHR, 2) fwd_kernel(Params p) {
    __builtin_assume(__builtin_amdgcn_workitem_id_y() == 0);
    __builtin_assume(__builtin_amdgcn_workitem_id_z() == 0);
    extern __shared__ __attribute__((aligned(16))) unsigned char smem[];
    cg::grid_group grid = cg::this_grid();
    const int lo = p.ph_lo, hi = p.ph_hi;
#ifndef ONLY
#define ONLY -1
#endif
#define IN(k) ((ONLY < 0 || ONLY == (k)) && lo <= (k) && (k) < hi)
#ifdef PROBE_A
#define STAMP(k) do { if (blockIdx.x == 0 && threadIdx.x == 0) ((unsigned long long*)(p.ws + OFF_CTL + 512))[k] = __builtin_amdgcn_s_memrealtime(); } while (0)
#else
#define STAMP(k) do {} while (0)
#endif
#define SYNC(k) do { if (IN(k) && IN((k) + 1)) { if ((k) == 0) { grid.sync(); xbar = xcd_barrier_post((unsigned*)(p.ws + OFF_BAR), xst); } else xcd_barrier(xbar); } STAMP((k) + 1); } while (0)
    unsigned* ctl = (unsigned*)(p.ws + OFF_CTL);
    volatile LAS unsigned* xst = (volatile LAS unsigned*)((LAS unsigned char*)smem + LDS_BYTES - 32);
    if (threadIdx.x < 2) xst[threadIdx.x] = 0u;
    __syncthreads();
    if (blockIdx.x == 0) for (int i = threadIdx.x; i < XCD_BAR_WORDS; i += NTHR) ((unsigned*)(p.ws + OFF_BAR))[i] = 0u;
    XcdBarrier xbar; xbar.bar = (unsigned*)(p.ws + OFF_BAR); xbar.x = 0; xbar.st = xst;
    STAMP(0);
    if (IN(0)) { if (blockIdx.x == 0 && threadIdx.x < 8) ctl[16 * threadIdx.x] = 0u;
        p0_weights(p); p0_tokens(p); }
    SYNC(0);
    if (IN(1)) { EpiProj e{(bf16_t*)(p.ws + OFF_PROJ)}; gemm_phase_p<EpiProj>((const bf16_t*)(p.ws + OFF_HN), DM, (const bf16_t*)(p.ws + OFF_WIN), T, NPROJ, DM, e, 0); }
    SYNC(1);
    if (IN(2)) {
        for (int u = blockIdx.x; u < NCHUNK * 4; u += gridDim.x) dn_prep_unit(p, u >> 2, u & 3);
    }
    SYNC(2);
    if (IN(3)) {
        for (int u = blockIdx.x; u < 192; u += gridDim.x) dn_scan_unit(p, u);
        STAMP(13);
        float l01 = 0.f, l23 = 0.f;
        for (int i = 0; i < 64; ++i) { l01 += p.da_lambda[i] * p.da_lambda[64 + i]; l23 += p.da_lambda[128 + i] * p.da_lambda[192 + i]; }
        const float lam = __expf(l01) - __expf(l23) + 0.2f;
        float gqm = 0.f, gkm = 0.f;
        for (int i = 0; i < 64; ++i) { gqm = fmaxf(gqm, fabsf(p.da_qk_norm_g[i])); gkm = fmaxf(gkm, fabsf(p.da_qk_norm_g[64 + i])); }
        const float negC = -64.f * 0.18033688f * gqm * gkm;
        int* sh = (int*)(smem + LDS_BYTES - 16);
        int victim = blockIdx.x & 7, tried = 0;
        while (true) {
            __syncthreads();
            if (threadIdx.x == 0) {
                int a = -1;
                while (tried < 8) {
                    const int j = (int)atomicAdd(ctl + 16 * victim, 1u);
                    if (j < 320) {
                        if (j < 256) { const int pair = victim + 8 * (j >> 5); a = pair * 32 + (j & 31); }
                        else { const int jj = j - 256; const int pair = victim + 8 * (jj >> 4); a = 2048 + pair * 16 + (jj & 15); }
                        break;
                    }
                    victim = (victim + 1) & 7; ++tried;
                }
                *sh = a;
            }
            __syncthreads();
            const int a = *sh;
            if (a < 0) break;
#ifndef SKIP_ATTN
            attn_unit<0>(p, a, lam, negC);
#endif
        }
    }
    SYNC(3);
    if (IN(4)) dn_combine(p);
    SYNC(4);
    if (IN(5)) { EpiResX e{{p.xp, p.xs, p.out}}; gemm_phase_p<EpiResX>((const bf16_t*)(p.ws + OFF_PROJ) + 1536, NPROJ, (const bf16_t*)(p.ws + OFF_WOUT), T, DM, DM, e, 0); }
    SYNC(5);
    if (IN(6)) { rmsnorm_pass(p.out, p.ln2_g, (bf16_t*)(p.ws + OFF_HN)); pe_convert(p); }
    SYNC(6);
    if (IN(7)) {
        EpiFfnP e{(bf16_t*)(p.ws + OFF_PROJ), (float*)(p.ws + OFF_GE), (float*)(p.ws + OFF_UE), p.ffn_conv_w, p.ffn_conv_b};
        gemm_phase_p<EpiFfnP>((const bf16_t*)(p.ws + OFF_HN), DM, (const bf16_t*)(p.ws + OFF_WUP), T, NUP, DM, e, 0);
        EpiEraw e2{(bf16_t*)(p.ws + OFF_ERAW), (float*)(p.ws + OFF_SSQ)};
        gemm_phase_p<EpiEraw>((const bf16_t*)(p.ws + OFF_PE), PLE, (const bf16_t*)(p.ws + OFF_WPLE), T, DM, PLE, e2, 128);
    }
    SYNC(7);
    if (IN(8)) ffn_edges(p);
    SYNC(8);
    if (IN(9)) { EpiAcc e{p.out}; gemm_phase_p<EpiAcc, true>((const bf16_t*)(p.ws + OFF_PROJ), DFF, (const bf16_t*)(p.ws + OFF_WDN), T, DM, DFF, e, 0); }
    SYNC(9);
    if (IN(10)) rmsnorm_pass(p.out, p.ple_gate_norm_g, (bf16_t*)(p.ws + OFF_HN));
    SYNC(10);
    if (IN(11)) {
        EpiFinal e{p.out, (const bf16_t*)(p.ws + OFF_ERAW), (const float*)(p.ws + OFF_SSQ), p.ple_norm_g};
        gemm_phase_p<EpiFinal>((const bf16_t*)(p.ws + OFF_HN), DM, (const bf16_t*)(p.ws + OFF_WG), T, DM, DM, e, 0);
    }
#ifdef DUMP_ON
    if (IN(12)) dump_phase(p);
#endif
#ifdef PROBE_A
    STAMP(12);
    grid.sync();
    if (blockIdx.x == 0) {
        const unsigned long long* ts = (const unsigned long long*)(p.ws + OFF_CTL + 512);
        const float dtA = (float)(ts[PROBE_A1] - ts[PROBE_A]) * 1e-5f, dtB = (float)(ts[PROBE_B1] - ts[PROBE_B]) * 1e-5f;
        if (threadIdx.x == 0) p.out[0] += 4.f * dtA;
        for (int j = threadIdx.x; j < 6711; j += NTHR) p.out[(size_t)TP * DM + j] += 0.5f * dtB;
    }
#endif
#undef IN
#undef SYNC
}

constexpr int NPHASE = 12;

extern "C" void kernel_launch(void* const* d_in, const int* in_sizes, int n_in, void* d_out, int out_size, void* d_ws, size_t ws_size, hipStream_t stream) {
    static int grid = 0;
    if (grid == 0) {
        if (n_in != 23 || ws_size < OFF_BAR + 16384) { fprintf(stderr, "kernel_launch: unexpected n_in %d / ws %zu (need %zu)\n", n_in, ws_size, (size_t)WS_END); grid = -1; return; }
        int dev = 0, cus = 0, per_cu = 0;
        hipGetDevice(&dev);
        hipDeviceGetAttribute(&cus, hipDeviceAttributeMultiprocessorCount, dev);
        if (hipFuncSetAttribute((const void*)fwd_kernel, hipFuncAttributeMaxDynamicSharedMemorySize, LDS_BYTES) != hipSuccess) { fprintf(stderr, "kernel_launch: hipFuncSetAttribute failed\n"); grid = -1; return; }
        if (hipOccupancyMaxActiveBlocksPerMultiprocessor(&per_cu, (const void*)fwd_kernel, NTHR, LDS_BYTES) != hipSuccess || per_cu < 1) { fprintf(stderr, "kernel_launch: occupancy query says %d\n", per_cu); per_cu = 1; }
        (void)hipGetLastError();
        grid = cus * per_cu;
    }
    if (grid < 0) return;
    Params p{};
    p.xp = (const float*)d_in[0]; p.xs = (const float*)d_in[1]; p.pp = (const float*)d_in[2]; p.ps = (const float*)d_in[3];
    p.ln1_g = (const float*)d_in[4]; p.w_in = (const float*)d_in[5]; p.dn_conv_w = (const float*)d_in[6]; p.dn_a_log = (const float*)d_in[7];
    p.dn_dt_bias = (const float*)d_in[8]; p.dn_norm_g = (const float*)d_in[9]; p.da_qk_norm_g = (const float*)d_in[10]; p.da_lambda = (const float*)d_in[11];
    p.da_subln_g = (const float*)d_in[12]; p.w_out = (const float*)d_in[13]; p.ln2_g = (const float*)d_in[14]; p.w_up = (const float*)d_in[15];
    p.ffn_conv_w = (const float*)d_in[16]; p.ffn_conv_b = (const float*)d_in[17]; p.w_down = (const float*)d_in[18]; p.ple_proj = (const float*)d_in[19];
    p.ple_norm_g = (const float*)d_in[20]; p.ple_gate_norm_g = (const float*)d_in[21]; p.w_ple_gate = (const float*)d_in[22];
    p.out = (float*)d_out; p.ws = (unsigned char*)d_ws;
#if COOP
    p.ph_lo = 0; p.ph_hi = NPHASE;
    void* args[] = {&p};
    hipError_t e = hipLaunchCooperativeKernel((const void*)fwd_kernel, dim3(grid), dim3(NTHR), args, LDS_BYTES, stream);
    if (e != hipSuccess) fprintf(stderr, "cooperative launch failed: %s (grid %d)\n", hipGetErrorString(e), grid);
#else
#ifndef PH_LIMIT
#define PH_LIMIT NPHASE
#endif
    for (int ph = 0; ph < PH_LIMIT; ++ph) {
        p.ph_lo = ph; p.ph_hi = ph + 1;
        hipLaunchKernelGGL(fwd_kernel, dim3(grid), dim3(NTHR), LDS_BYTES, stream, p);
    }
#ifdef DUMP_ON
    p.ph_lo = 12; p.ph_hi = 13;
    hipLaunchKernelGGL(fwd_kernel, dim3(grid), dim3(NTHR), LDS_BYTES, stream, p);
#endif
#endif
}
```

```cpp
#include <hip/hip_runtime.h>
#include <hip/hip_cooperative_groups.h>
#include <cstdio>
#include <cstdint>
namespace cg = cooperative_groups;

typedef unsigned short bf16_t;
typedef short bf16x8 __attribute__((ext_vector_type(8)));
typedef float f32x4 __attribute__((ext_vector_type(4)));
typedef unsigned u32x4 __attribute__((ext_vector_type(4)));
typedef unsigned u32x2 __attribute__((ext_vector_type(2)));

#ifndef COOP
#define COOP 1
#endif

constexpr int T = 81920, TP = 16384, DM = 1024, NPROJ = 3584, NIN = 3600, DFF = 2816, NUP = 5632, PLE = 256;
constexpr int NTHR = 512;
constexpr int NCHUNK = T / 64;
constexpr float EPS = 1e-6f;
constexpr int LDS_BYTES = 139264;

constexpr size_t OFF_CTL = 0;
constexpr size_t OFF_WIN = 4096;
constexpr size_t OFF_WOUT = OFF_WIN + (size_t)NPROJ * DM * 2;
constexpr size_t OFF_WUP = OFF_WOUT + (size_t)DM * DM * 2;
constexpr size_t OFF_WDN = OFF_WUP + (size_t)NUP * DM * 2;
constexpr size_t OFF_WPLE = OFF_WDN + (size_t)DM * DFF * 2;
constexpr size_t OFF_WG = OFF_WPLE + (size_t)DM * PLE * 2;
constexpr size_t OFF_DAB = OFF_WG + (size_t)DM * DM * 2;
constexpr size_t OFF_GC = OFF_DAB + (size_t)T * 16 * 4;
constexpr size_t OFF_SSQ = OFF_GC + (size_t)8 * T * 4;
constexpr size_t OFF_HN = OFF_SSQ + (size_t)T * 16 * 4;
constexpr size_t OFF_PROJ = OFF_HN + (size_t)T * DM * 2;
constexpr size_t OFF_QK = OFF_PROJ + (size_t)T * NPROJ * 2;
constexpr size_t WS_END = OFF_QK + (size_t)3 * T * 512 * 2;
constexpr size_t OFF_QN = OFF_QK;
constexpr size_t OFF_KN = OFF_QK + (size_t)T * 512 * 2;
constexpr size_t OFF_KNT = OFF_QK + (size_t)2 * T * 512 * 2;
constexpr size_t OFF_ERAW = OFF_QK;
constexpr size_t OFF_GE = OFF_ERAW + (size_t)T * DM * 2;
constexpr size_t OFF_UE = OFF_GE + (size_t)320 * 4 * DFF * 4;
constexpr size_t OFF_PE = OFF_UE + (size_t)320 * 2 * DFF * 4;
static_assert(OFF_PE + (size_t)T * PLE * 2 <= WS_END, "overlay");
constexpr size_t OFF_BAR = WS_END;
static_assert(OFF_BAR + 16384 <= (size_t)1073741824, "ws");

struct Params {
    const float* xp; const float* xs; const float* pp; const float* ps;
    const float* ln1_g; const float* w_in; const float* dn_conv_w; const float* dn_a_log; const float* dn_dt_bias; const float* dn_norm_g;
    const float* da_qk_norm_g; const float* da_lambda; const float* da_subln_g; const float* w_out; const float* ln2_g; const float* w_up;
    const float* ffn_conv_w; const float* ffn_conv_b; const float* w_down; const float* ple_proj; const float* ple_norm_g; const float* ple_gate_norm_g; const float* w_ple_gate;
    float* out; unsigned char* ws;
    int ph_lo, ph_hi;
};

typedef float f32x2 __attribute__((ext_vector_type(2)));
typedef __bf16 bf16x2v __attribute__((ext_vector_type(2)));
__device__ __forceinline__ unsigned pk2(float lo, float hi) { const f32x2 v = {lo, hi}; const bf16x2v b = __builtin_convertvector(v, bf16x2v); return __builtin_bit_cast(unsigned, b); }
__device__ __forceinline__ float bflo(unsigned u) { return __uint_as_float(u << 16); }
__device__ __forceinline__ float bfhi(unsigned u) { return __uint_as_float(u & 0xffff0000u); }
__device__ __forceinline__ float bf2f(bf16_t h) { return __uint_as_float(((unsigned)h) << 16); }
__device__ __forceinline__ bf16_t f2bf(float f) { return (bf16_t)(pk2(f, 0.f) & 0xffffu); }
__device__ __forceinline__ float siluf(float x) { return x / (1.f + __expf(-x)); }
__device__ __forceinline__ float sigmoidf_(float x) { return 1.f / (1.f + __expf(-x)); }
__device__ __forceinline__ void tok_seq(int t, int& s0, int& S) { if (t < TP) { S = 2048; s0 = t & ~2047; } else { S = 4096; s0 = TP + ((t - TP) & ~4095); } }
__device__ __forceinline__ const float* xrow(const Params& p, int r) { return r < TP ? p.xp + (size_t)r * DM : p.xs + (size_t)(r - TP) * DM; }
__device__ __forceinline__ const float* prow(const Params& p, int r) { return r < TP ? p.pp + (size_t)r * PLE : p.ps + (size_t)(r - TP) * PLE; }
__device__ __forceinline__ float wave_sum(float v) {
#pragma unroll
    for (int o = 32; o >= 1; o >>= 1) v += __shfl_xor(v, o);
    return v;
}
#define MFMA16(a, b, c) __builtin_amdgcn_mfma_f32_16x16x32_bf16((a), (b), (c), 0, 0, 0)

__device__ void p0_weights(const Params& p) {
    extern __shared__ __attribute__((aligned(16))) unsigned char smem[];
    float* tile = (float*)smem;
    const int tid = threadIdx.x;
    const int n0 = 896, n1 = n0 + 256, n2 = n1 + 1408, n3 = n2 + 704, n4 = n3 + 64, n5 = n4 + 256;
    for (int tix = blockIdx.x; tix < n5; tix += gridDim.x) {
        const float* src; int ldsrc, K, mode, loc; bf16_t* dst;
        if (tix < n0) { src = p.w_in; ldsrc = NIN; K = DM; mode = 0; loc = tix; dst = (bf16_t*)(p.ws + OFF_WIN); }
        else if (tix < n1) { src = p.w_out; ldsrc = DM; K = DM; mode = 1; loc = tix - n0; dst = (bf16_t*)(p.ws + OFF_WOUT); }
        else if (tix < n2) { src = p.w_up; ldsrc = NUP; K = DM; mode = 2; loc = tix - n1; dst = (bf16_t*)(p.ws + OFF_WUP); }
        else if (tix < n3) { src = p.w_down; ldsrc = DM; K = DFF; mode = 1; loc = tix - n2; dst = (bf16_t*)(p.ws + OFF_WDN); }
        else if (tix < n4) { src = p.ple_proj; ldsrc = DM; K = PLE; mode = 1; loc = tix - n3; dst = (bf16_t*)(p.ws + OFF_WPLE); }
        else { src = p.w_ple_gate; ldsrc = DM; K = DM; mode = 1; loc = tix - n4; dst = (bf16_t*)(p.ws + OFF_WG); }
        const int nkt = K / 64, nt = loc / nkt, kt = loc % nkt;
        const int nbase = nt * 64;
        int cbase;
        if (mode == 0) cbase = nbase < 2048 ? nbase : nbase + 16;
        else if (mode == 2) { const int g = nbase >> 8, w = nbase & 255; cbase = (w < 128) ? g * 128 + w : DFF + g * 128 + (w - 128); }
        else cbase = nbase;
        const int c = tid & 63, r0 = tid >> 6;
#pragma unroll
        for (int i = 0; i < 8; ++i) { const int r = r0 + 8 * i; tile[r * 65 + c] = src[(size_t)(kt * 64 + r) * ldsrc + cbase + c]; }
        __syncthreads();
#pragma unroll
        for (int i = 0; i < 8; ++i) { const int n = r0 + 8 * i;
            const int rho = n & 31, ii = rho & 15, ns = (n & 32) + 8 * (ii >> 2) + 4 * (rho >> 4) + (ii & 3);
            dst[(size_t)(nbase + n) * K + kt * 64 + c] = f2bf(tile[c * 65 + ns]); }
        __syncthreads();
    }
}

__device__ void p0_tokens(const Params& p) {
    extern __shared__ __attribute__((aligned(16))) unsigned char smem[];
    float* Wd = (float*)smem;
    const int tid = threadIdx.x, lane = tid & 63, wave = tid >> 6;
    for (int idx = tid; idx < 16384; idx += NTHR) { const int c = idx >> 4, k = idx & 15; Wd[k * 1024 + c] = p.w_in[(size_t)c * NIN + 2048 + k]; }
    __syncthreads();
    bf16_t* hn = (bf16_t*)(p.ws + OFF_HN);
    float* dab = (float*)(p.ws + OFF_DAB);
    const int step = gridDim.x * 8;
    f32x4 vn[2][4];
    {
#pragma unroll
        for (int q = 0; q < 2; ++q) { const int r = blockIdx.x * 8 + wave + q * step; if (r < T) { const float* xr = xrow(p, r);
#pragma unroll
            for (int i = 0; i < 4; ++i) vn[q][i] = *(const f32x4*)(xr + i * 256 + lane * 4); } }
    }
    f32x4 g1[4];
#pragma unroll
    for (int i = 0; i < 4; ++i) g1[i] = *(const f32x4*)(p.ln1_g + i * 256 + lane * 4);
    for (int r0 = blockIdx.x * 8 + wave; r0 < T; r0 += 2 * step) {
        f32x4 v[2][4];
        float ss[2] = {0.f, 0.f};
#pragma unroll
        for (int q = 0; q < 2; ++q)
#pragma unroll
            for (int i = 0; i < 4; ++i) { v[q][i] = vn[q][i]; ss[q] += v[q][i][0] * v[q][i][0] + v[q][i][1] * v[q][i][1] + v[q][i][2] * v[q][i][2] + v[q][i][3] * v[q][i][3]; }
#pragma unroll
        for (int q = 0; q < 2; ++q) { const int rn = r0 + (2 + q) * step; if (rn < T) { const float* xr = xrow(p, rn);
#pragma unroll
            for (int i = 0; i < 4; ++i) vn[q][i] = *(const f32x4*)(xr + i * 256 + lane * 4); } }
        const bool has1 = (r0 + step) < T;
#pragma unroll
        for (int q = 0; q < 2; ++q) {
            ss[q] = wave_sum(ss[q]);
            const float rs = rsqrtf(ss[q] * (1.f / DM) + EPS);
            const int r = r0 + q * step;
#pragma unroll
            for (int i = 0; i < 4; ++i) {
                v[q][i] = v[q][i] * rs * g1[i];
                if (q == 0 || has1) { u32x2 o; o[0] = pk2(v[q][i][0], v[q][i][1]); o[1] = pk2(v[q][i][2], v[q][i][3]); *(u32x2*)(hn + (size_t)r * DM + i * 256 + lane * 4) = o; }
            }
        }
        float my0 = 0.f, my1 = 0.f;
#pragma unroll 2
        for (int k = 0; k < 16; ++k) {
            float a0 = 0.f, a1 = 0.f;
#pragma unroll
            for (int i = 0; i < 4; ++i) { const f32x4 w = *(const f32x4*)(Wd + k * 1024 + i * 256 + lane * 4);
                a0 += v[0][i][0] * w[0] + v[0][i][1] * w[1] + v[0][i][2] * w[2] + v[0][i][3] * w[3];
                a1 += v[1][i][0] * w[0] + v[1][i][1] * w[1] + v[1][i][2] * w[2] + v[1][i][3] * w[3]; }
            a0 = wave_sum(a0); a1 = wave_sum(a1);
            if (lane == k) { my0 = a0; my1 = a1; }
        }
        if (lane < 16) { dab[(size_t)r0 * 16 + lane] = my0; if (has1) dab[(size_t)(r0 + step) * 16 + lane] = my1; }
    }
    __syncthreads();
}

__device__ void rmsnorm_pass(const float* src, const float* g, bf16_t* hn) {
    const int tid = threadIdx.x, lane = tid & 63, wave = tid >> 6;
    constexpr int RB = 4;
    f32x4 gg[4];
#pragma unroll
    for (int i = 0; i < 4; ++i) gg[i] = *(const f32x4*)(g + i * 256 + lane * 4);
    for (int r0 = (blockIdx.x * 8 + wave) * RB; r0 < T; r0 += gridDim.x * 8 * RB) {
        f32x4 v[RB][4];
#pragma unroll
        for (int k = 0; k < RB; ++k)
#pragma unroll
            for (int i = 0; i < 4; ++i) v[k][i] = *(const f32x4*)(src + (size_t)(r0 + k) * DM + i * 256 + lane * 4);
#pragma unroll
        for (int k = 0; k < RB; ++k) {
            float ss = 0.f;
#pragma unroll
            for (int i = 0; i < 4; ++i) ss += v[k][i][0] * v[k][i][0] + v[k][i][1] * v[k][i][1] + v[k][i][2] * v[k][i][2] + v[k][i][3] * v[k][i][3];
            ss = wave_sum(ss);
            const float rs = rsqrtf(ss * (1.f / DM) + EPS);
#pragma unroll
            for (int i = 0; i < 4; ++i) {
                const f32x4 y = v[k][i] * rs * gg[i];
                u32x2 o; o[0] = pk2(y[0], y[1]); o[1] = pk2(y[2], y[3]);
                *(u32x2*)(hn + (size_t)(r0 + k) * DM + i * 256 + lane * 4) = o;
            }
        }
    }
}

constexpr int BM = 256, BK = 64, HALF = 128, HT = HALF * BK;
__device__ __forceinline__ int lds_byte(int r, int c) { int st = (r >> 4) * 2 + (c >> 5), rr = r & 15, cc = c & 31, ob = rr * 64 + cc * 2; return st * 1024 + (ob ^ (((ob >> 9) & 1) << 5)); }
__device__ __forceinline__ void stage_rc(int b, int& R, int& C) { int st = b / 1024, sb = b % 1024, swz = sb ^ (((sb >> 9) & 1) << 5); R = (st >> 1) * 16 + swz / 64; C = (st & 1) * 32 + (swz % 64) / 2; }

#define LAS __attribute__((address_space(3)))
constexpr int HTB = HT * 2;
template <class Epi>
__device__ __forceinline__ void gemm_tile(const bf16_t* __restrict__ A, const int lda, const bf16_t* __restrict__ Bt, const int K, const int pm, const int pn, const Epi& epi) {
    extern __shared__ __attribute__((aligned(16))) unsigned char smem[];
    LAS unsigned char* lds = (LAS unsigned char*)smem;
    const int tid = threadIdx.x, wid = __builtin_amdgcn_readfirstlane(tid >> 6), lane = tid & 63, wr = wid >> 2, wc = wid & 3, fr = lane & 15, fq = lane >> 4;
    unsigned voffA[2], voffB[2];
#pragma unroll
    for (int i = 0; i < 2; ++i) { int R, C; stage_rc(tid * 16 + i * 8192, R, C); voffA[i] = (unsigned)(R * lda + C) * 2u; voffB[i] = (unsigned)(R * K + C) * 2u; }
    const unsigned ldsw = (unsigned)wid * 1024u;
    const int aoff = lds_byte(wr * 64 + fr, fq * 8), boff = lds_byte(wc * 32 + fr, fq * 8);
    const bf16_t* Ab0 = A + (size_t)(pm * BM) * lda;
    const bf16_t* Ab1 = Ab0 + (size_t)HALF * lda;
    const bf16_t* Bb0 = Bt + (size_t)(pn * BM) * K;
    const bf16_t* Bb1 = Bb0 + (size_t)HALF * K;
#define SA(b, h) (((b) * 2 + (h)) * HTB)
#define SB(b, h) ((4 + (b) * 2 + (h)) * HTB)
#define STAGE(bufoff, gbase, voff) do { _Pragma("unroll") for (int _i = 0; _i < 2; ++_i) \
      __builtin_amdgcn_global_load_lds((const unsigned*)((const char*)(gbase) + (voff)[_i]), (LAS unsigned*)(lds + (bufoff) + ldsw + _i * 8192), 16, 0, 0); } while (0)
#define STA(b, h, kt) STAGE(SA(b, h), ((h) ? Ab1 : Ab0) + (size_t)(kt) * BK, voffA)
#define STB(b, h, kt) STAGE(SB(b, h), ((h) ? Bb1 : Bb0) + (size_t)(kt) * BK, voffB)
#define LDA(dst, b, h) do { _Pragma("unroll") for (int m = 0; m < 4; ++m) _Pragma("unroll") for (int k = 0; k < 2; ++k) dst[m][k] = *(const LAS bf16x8*)(lds + SA(b, h) + aoff + m * 2048 + k * 1024); } while (0)
#define LDB(dst, b, h) do { _Pragma("unroll") for (int n = 0; n < 2; ++n) _Pragma("unroll") for (int k = 0; k < 2; ++k) dst[n][k] = *(const LAS bf16x8*)(lds + SB(b, h) + boff + n * 2048 + k * 1024); } while (0)
#define MMA(ai, bj, At_, Bt_) do { __builtin_amdgcn_s_setprio(1); \
    _Pragma("unroll") for (int m = 0; m < 4; ++m) _Pragma("unroll") for (int n = 0; n < 2; ++n) _Pragma("unroll") for (int k = 0; k < 2; ++k) \
      acc[ai][bj][m][n] = __builtin_amdgcn_mfma_f32_16x16x32_bf16(Bt_[n][k], At_[m][k], acc[ai][bj][m][n], 0, 0, 0); \
    __builtin_amdgcn_s_setprio(0); } while (0)
#define WAIT_V(n) asm volatile("s_waitcnt vmcnt(" #n ")" ::: "memory")
#define WAIT_L(n) asm volatile("s_waitcnt lgkmcnt(" #n ")" ::: "memory")
#define BAR __builtin_amdgcn_s_barrier()
#define SCHED __builtin_amdgcn_sched_barrier(0)
    f32x4 acc[2][2][4][2];
#pragma unroll
    for (int a = 0; a < 2; ++a)
#pragma unroll
        for (int b = 0; b < 2; ++b)
#pragma unroll
            for (int m = 0; m < 4; ++m)
#pragma unroll
                for (int n = 0; n < 2; ++n) acc[a][b][m][n] = (f32x4){0.f, 0.f, 0.f, 0.f};
    bf16x8 At[4][2], B0[2][2], B1[2][2];
    const int nt = K / BK;
    STB(0, 0, 0); STA(0, 0, 0);
    STB(0, 1, 0); STA(0, 1, 0);
    if (wr == 1) BAR;
    WAIT_V(4); BAR;
    STB(1, 0, 1); STA(1, 0, 1); STB(1, 1, 1);
    WAIT_V(6); BAR;
    for (int t = 0; t < nt - 2; t += 2) {
        LDB(B0, 0, 0); SCHED; LDA(At, 0, 0); STA(1, 1, t + 1);
        WAIT_L(8); BAR; WAIT_L(0); MMA(0, 0, At, B0); BAR; SCHED;
        LDB(B1, 0, 1); STB(0, 0, t + 2);
        BAR; WAIT_L(0); MMA(0, 1, At, B1); BAR;
        LDA(At, 0, 1); STA(0, 0, t + 2);
        BAR; WAIT_L(0); MMA(1, 0, At, B0); BAR; SCHED;
        STB(0, 1, t + 2);
        WAIT_V(6); BAR; MMA(1, 1, At, B1); BAR;
        LDB(B0, 1, 0); SCHED; LDA(At, 1, 0); STA(0, 1, t + 2);
        WAIT_L(8); BAR; WAIT_L(0); MMA(0, 0, At, B0); BAR; SCHED;
        LDB(B1, 1, 1); STB(1, 0, t + 3);
        BAR; WAIT_L(0); MMA(0, 1, At, B1); BAR;
        LDA(At, 1, 1); STA(1, 0, t + 3);
        BAR; WAIT_L(0); MMA(1, 0, At, B0); BAR; SCHED;
        STB(1, 1, t + 3);
        WAIT_V(6); BAR; MMA(1, 1, At, B1); BAR;
    }
    { LDB(B0, 0, 0); LDA(At, 0, 0); STA(1, 1, nt - 1);
      BAR; WAIT_L(0); MMA(0, 0, At, B0); BAR;
      LDB(B1, 0, 1); BAR; WAIT_L(0); MMA(0, 1, At, B1); BAR;
      LDA(At, 0, 1); WAIT_V(4); BAR; WAIT_L(0); MMA(1, 0, At, B0); MMA(1, 1, At, B1); BAR; }
    { LDB(B0, 1, 0); LDA(At, 1, 0); WAIT_V(2); BAR; WAIT_L(0); MMA(0, 0, At, B0); BAR;
      LDB(B1, 1, 1); WAIT_V(0); BAR; WAIT_L(0); MMA(0, 1, At, B1); BAR;
      LDA(At, 1, 1); BAR; WAIT_L(0); MMA(1, 0, At, B0); MMA(1, 1, At, B1); BAR; }
    if (wr == 0) BAR;
    epi(acc, pm, pn, wr, wc, fr, fq);
#undef SA
#undef SB
#undef STAGE
#undef STA
#undef STB
#undef LDA
#undef LDB
#undef MMA
}

__device__ __forceinline__ bool tile_of(int L, int nM, int nN, int& pm, int& pn) {
    const int nwg = nM * nN;
    if (L >= nwg) return false;
    int wgid = L;
    { const int q = nwg / 8, r = nwg % 8, xcd = wgid % 8, off = wgid / 8; wgid = (xcd < r ? xcd * (q + 1) : r * (q + 1) + (xcd - r) * q) + off; }
    const int nig = 8 * nN, gid = wgid / nig, fm = gid * 8, gsz = (nM - fm) < 8 ? (nM - fm) : 8;
    pm = fm + ((wgid % nig) % gsz); pn = (wgid % nig) / gsz;
    return true;
}

template <class Epi>
__device__ __forceinline__ void gemm_phase(const bf16_t* A, int lda, const bf16_t* Bt, int M, int N, int K, const Epi& epi, int rot) {
    const int nM = M / BM, nN = N / BM;
    const int G = gridDim.x;
    int c = (int)blockIdx.x + rot; if (c >= G) c -= G;
    for (int L = c; ; L += G) {
        int pm, pn;
        if (!tile_of(L, nM, nN, pm, pn)) break;
        gemm_tile<Epi>(A, lda, Bt, K, pm, pn, epi);
    }
}

template <class Epi, bool PACKA = false>
__device__ __forceinline__ void gemm_phase_p(const bf16_t* __restrict__ A, const int lda, const bf16_t* __restrict__ Bt, int M, int N, const int K, const Epi& epi, int rot, int L0 = -1, int Lstep = 0, int Lcnt = 1 << 30) {
    extern __shared__ __attribute__((aligned(16))) unsigned char smem[];
    LAS unsigned char* lds = (LAS unsigned char*)smem;
    const int nM = M / BM, nN = N / BM;
    const int G = gridDim.x;
    int c = (int)blockIdx.x + rot; if (c >= G) c -= G;
    int pm, pn, npm, npn;
    if (L0 >= 0) c = L0;
    const int G2 = (L0 >= 0) ? Lstep : G;
    if (Lcnt <= 0 || !tile_of(c, nM, nN, pm, pn)) return;
    const int tid = threadIdx.x, wid = __builtin_amdgcn_readfirstlane(tid >> 6), lane = tid & 63, wr = wid >> 2, wc = wid & 3, fr = lane & 15, fq = lane >> 4;
    unsigned voffA[2], voffB[2];
#pragma unroll
    for (int i = 0; i < 2; ++i) { int R, C; stage_rc(tid * 16 + i * 8192, R, C); voffA[i] = (unsigned)(R * (PACKA ? 64 : lda) + C) * 2u; voffB[i] = (unsigned)(R * K + C) * 2u; }
    const unsigned ldsw = (unsigned)wid * 1024u;
    const int aoff = lds_byte(wr * 64 + fr, fq * 8), boff = lds_byte(wc * 32 + fr, fq * 8);
    const int nt = K / BK;
    const size_t kstep = (size_t)BK * 2, kA = PACKA ? (size_t)256 * 64 * 2 : kstep, hA = PACKA ? (size_t)HALF * 64 * 2 : (size_t)HALF * lda * 2, hB = (size_t)HALF * K * 2,
                 tA = PACKA ? (size_t)nt * 256 * 64 * 2 : 2 * hA, tB = 2 * hB;
#define SA(b, h) (((b) * 2 + (h)) * HTB)
#define SB(b, h) ((4 + (b) * 2 + (h)) * HTB)
#define STAGE(bufoff, gbase, voff) do { _Pragma("unroll") for (int _i = 0; _i < 2; ++_i) \
      __builtin_amdgcn_global_load_lds((const unsigned*)((const char*)(gbase) + (voff)[_i]), (LAS unsigned*)(lds + (bufoff) + ldsw + _i * 8192), 16, 0, 0); } while (0)
#define LDA(dst, b, h) do { _Pragma("unroll") for (int m = 0; m < 4; ++m) _Pragma("unroll") for (int k = 0; k < 2; ++k) dst[m][k] = *(const LAS bf16x8*)(lds + SA(b, h) + aoff + m * 2048 + k * 1024); } while (0)
#define LDB(dst, b, h) do { _Pragma("unroll") for (int n = 0; n < 2; ++n) _Pragma("unroll") for (int k = 0; k < 2; ++k) dst[n][k] = *(const LAS bf16x8*)(lds + SB(b, h) + boff + n * 2048 + k * 1024); } while (0)
#define MMA(ai, bj, At_, Bt_) do { __builtin_amdgcn_s_setprio(1); \
    _Pragma("unroll") for (int m = 0; m < 4; ++m) _Pragma("unroll") for (int n = 0; n < 2; ++n) _Pragma("unroll") for (int k = 0; k < 2; ++k) \
      acc[ai][bj][m][n] = __builtin_amdgcn_mfma_f32_16x16x32_bf16(Bt_[n][k], At_[m][k], acc[ai][bj][m][n], 0, 0, 0); \
    __builtin_amdgcn_s_setprio(0); } while (0)
    f32x4 acc[2][2][4][2];
#pragma unroll
    for (int a = 0; a < 2; ++a)
#pragma unroll
        for (int b = 0; b < 2; ++b)
#pragma unroll
            for (int m = 0; m < 4; ++m)
#pragma unroll
                for (int n = 0; n < 2; ++n) acc[a][b][m][n] = (f32x4){0.f, 0.f, 0.f, 0.f};
    bf16x8 At[4][2], B0[2][2], B1[2][2];
    const char* cA = (const char*)A + (size_t)pm * tA; const char* cB = (const char*)Bt + (size_t)pn * tB;
    STAGE(SB(0, 0), cB, voffB); STAGE(SA(0, 0), cA, voffA); STAGE(SB(0, 1), cB + hB, voffB); STAGE(SA(0, 1), cA + hA, voffA);
    if (wr == 1) BAR;
    WAIT_V(4); BAR;
    STAGE(SB(1, 0), cB + kstep, voffB); STAGE(SA(1, 0), cA + kA, voffA); STAGE(SB(1, 1), cB + hB + kstep, voffB);
    WAIT_V(6); BAR;
    int L = c, li = 0;
    for (;;) {
        const bool has_next = (li + 1 < Lcnt) && tile_of(L + G2, nM, nN, npm, npn);
        const char* nA = has_next ? (const char*)A + (size_t)npm * tA : cA; const char* nB = has_next ? (const char*)Bt + (size_t)npn * tB : cB;
        for (int t = 0; t < nt; t += 2) {
            const bool last = (t == nt - 2);
            const char* a1 = cA + (size_t)(t + 1) * kA;
            const char* a2 = last ? nA : cA + (size_t)(t + 2) * kA; const char* b2 = last ? nB : cB + (size_t)(t + 2) * kstep;
            const char* a3 = a2 + kA; const char* b3 = b2 + kstep;
            LDB(B0, 0, 0); SCHED; LDA(At, 0, 0); STAGE(SA(1, 1), a1 + hA, voffA);
            WAIT_L(8); BAR; WAIT_L(0); MMA(0, 0, At, B0); BAR; SCHED;
            LDB(B1, 0, 1); STAGE(SB(0, 0), b2, voffB);
            BAR; WAIT_L(0); MMA(0, 1, At, B1); BAR;
            LDA(At, 0, 1); STAGE(SA(0, 0), a2, voffA);
            BAR; WAIT_L(0); MMA(1, 0, At, B0); BAR; SCHED;
            STAGE(SB(0, 1), b2 + hB, voffB);
            WAIT_V(6); BAR; MMA(1, 1, At, B1); BAR;
            LDB(B0, 1, 0); SCHED; LDA(At, 1, 0); STAGE(SA(0, 1), a2 + hA, voffA);
            WAIT_L(8); BAR; WAIT_L(0); MMA(0, 0, At, B0); BAR; SCHED;
            LDB(B1, 1, 1); STAGE(SB(1, 0), b3, voffB);
            BAR; WAIT_L(0); MMA(0, 1, At, B1); BAR;
            LDA(At, 1, 1); STAGE(SA(1, 0), a3, voffA);
            BAR; WAIT_L(0); MMA(1, 0, At, B0); BAR; SCHED;
            STAGE(SB(1, 1), b3 + hB, voffB);
            WAIT_V(6); BAR; MMA(1, 1, At, B1); BAR;
        }
        epi(acc, pm, pn, wr, wc, fr, fq);
        if (!has_next) break;
#pragma unroll
        for (int a = 0; a < 2; ++a)
#pragma unroll
            for (int b = 0; b < 2; ++b)
#pragma unroll
                for (int m = 0; m < 4; ++m)
#pragma unroll
                    for (int n = 0; n < 2; ++n) acc[a][b][m][n] = (f32x4){0.f, 0.f, 0.f, 0.f};
        pm = npm; pn = npn; cA = nA; cB = nB; L += G2; ++li;
    }
    WAIT_V(0);
    if (wr == 0) BAR;
    BAR;
#undef SA
#undef SB
#undef STAGE
#undef LDA
#undef LDB
#undef MMA
}

typedef f32x4 AccT[2][2][4][2];

struct EpiProj {
    bf16_t* P;
    __device__ __forceinline__ void operator()(const AccT& acc, int pm, int pn, int wr, int wc, int fr, int fq) const {
#pragma unroll
        for (int ai = 0; ai < 2; ++ai)
#pragma unroll
            for (int m = 0; m < 4; ++m) {
                const int row = pm * 256 + ai * 128 + wr * 64 + m * 16 + fr;
#pragma unroll
                for (int bj = 0; bj < 2; ++bj) {
                    const int col = pn * 256 + bj * 128 + wc * 32 + fq * 8;
                    const f32x4 v0 = acc[ai][bj][m][0], v1 = acc[ai][bj][m][1];
                    *(u32x4*)(P + (size_t)row * NPROJ + col) = (u32x4){pk2(v0[0], v0[1]), pk2(v0[2], v0[3]), pk2(v1[0], v1[1]), pk2(v1[2], v1[3])};
                }
            }
    }
};

struct EpiResX {
    struct { const float* xp; const float* xs; float* out; } p;
    __device__ __forceinline__ void operator()(const AccT& acc, int pm, int pn, int wr, int wc, int fr, int fq) const {
#pragma unroll
        for (int ai = 0; ai < 2; ++ai)
#pragma unroll
            for (int m = 0; m < 4; ++m) {
                const int row = pm * 256 + ai * 128 + wr * 64 + m * 16 + fr;
                const float* xr = row < TP ? p.xp + (size_t)row * DM : p.xs + (size_t)(row - TP) * DM;
#pragma unroll
                for (int bj = 0; bj < 2; ++bj)
#pragma unroll
                    for (int n = 0; n < 2; ++n) {
                        const int col = pn * 256 + bj * 128 + wc * 32 + fq * 8 + n * 4;
                        const f32x4 xv = *(const f32x4*)(xr + col);
                        *(f32x4*)(p.out + (size_t)row * DM + col) = xv + acc[ai][bj][m][n];
                    }
            }
    }
};

struct EpiAcc {
    float* out;
    __device__ __forceinline__ void operator()(const AccT& acc, int pm, int pn, int wr, int wc, int fr, int fq) const {
#pragma unroll
        for (int ai = 0; ai < 2; ++ai)
#pragma unroll
            for (int m = 0; m < 4; ++m) {
                const int row = pm * 256 + ai * 128 + wr * 64 + m * 16 + fr;
#pragma unroll
                for (int bj = 0; bj < 2; ++bj)
#pragma unroll
                    for (int n = 0; n < 2; ++n) {
                        const int col = pn * 256 + bj * 128 + wc * 32 + fq * 8 + n * 4;
                        float* o = out + (size_t)row * DM + col;
                        *(f32x4*)o = *(const f32x4*)o + acc[ai][bj][m][n];
                    }
            }
    }
};

struct EpiEraw {
    bf16_t* E; float* ssq;
    __device__ __forceinline__ void operator()(const AccT& acc, int pm, int pn, int wr, int wc, int fr, int fq) const {
#pragma unroll
        for (int ai = 0; ai < 2; ++ai)
#pragma unroll
            for (int m = 0; m < 4; ++m) {
                const int row = pm * 256 + ai * 128 + wr * 64 + m * 16 + fr;
                float s = 0.f;
#pragma unroll
                for (int bj = 0; bj < 2; ++bj) {
                    const int col = pn * 256 + bj * 128 + wc * 32 + fq * 8;
                    const f32x4 v0 = acc[ai][bj][m][0], v1 = acc[ai][bj][m][1];
                    s += v0[0] * v0[0] + v0[1] * v0[1] + v0[2] * v0[2] + v0[3] * v0[3] + v1[0] * v1[0] + v1[1] * v1[1] + v1[2] * v1[2] + v1[3] * v1[3];
                    *(u32x4*)(E + (size_t)row * DM + col) = (u32x4){pk2(v0[0], v0[1]), pk2(v0[2], v0[3]), pk2(v1[0], v1[1]), pk2(v1[2], v1[3])};
                }
                s += __shfl_xor(s, 16); s += __shfl_xor(s, 32);
                if (fq == 0) ssq[(size_t)row * 16 + pn * 4 + wc] = s;
            }
    }
};

struct EpiFinal {
    float* out; const bf16_t* E; const float* ssq; const float* ge;
    __device__ __forceinline__ void operator()(const AccT& acc, int pm, int pn, int wr, int wc, int fr, int fq) const {
#pragma unroll
        for (int ai = 0; ai < 2; ++ai)
#pragma unroll
            for (int m = 0; m < 4; ++m) {
                const int row = pm * 256 + ai * 128 + wr * 64 + m * 16 + fr;
                float s = 0.f;
#pragma unroll
                for (int q = 0; q < 4; ++q) { const f32x4 v = *(const f32x4*)(ssq + (size_t)row * 16 + q * 4); s += v[0] + v[1] + v[2] + v[3]; }
                const float rs = rsqrtf(s * (1.f / DM) + EPS);
#pragma unroll
                for (int bj = 0; bj < 2; ++bj)
#pragma unroll
                    for (int n = 0; n < 2; ++n) {
                        const int col = pn * 256 + bj * 128 + wc * 32 + fq * 8 + n * 4;
                        const u32x2 e = *(const u32x2*)(E + (size_t)row * DM + col);
                        const f32x4 g = *(const f32x4*)(ge + col);
                        const f32x4 a = acc[ai][bj][m][n];
                        f32x4 r;
                        r[0] = sigmoidf_(a[0]) * bflo(e[0]) * rs * g[0];
                        r[1] = sigmoidf_(a[1]) * bfhi(e[0]) * rs * g[1];
                        r[2] = sigmoidf_(a[2]) * bflo(e[1]) * rs * g[2];
                        r[3] = sigmoidf_(a[3]) * bfhi(e[1]) * rs * g[3];
                        float* o = out + (size_t)row * DM + col;
                        *(f32x4*)o = *(const f32x4*)o + r;
                    }
            }
    }
};

struct EpiFfn {
    bf16_t* H; float* ge; float* ue; const float* cw; const float* cb;
    __device__ __forceinline__ void operator()(const AccT& acc, int pm, int pn, int wr, int wc, int fr, int fq) const {
        extern __shared__ __attribute__((aligned(16))) unsigned char smem[];
        float* G = (float*)smem;
#pragma unroll
        for (int ai = 0; ai < 2; ++ai)
#pragma unroll
            for (int m = 0; m < 4; ++m) {
                const int r = ai * 128 + wr * 64 + m * 16 + fr;
#pragma unroll
                for (int n = 0; n < 2; ++n) *(f32x4*)(G + r * 132 + wc * 32 + fq * 8 + n * 4) = acc[ai][0][m][n];
            }
        __syncthreads();
#pragma unroll
        for (int n = 0; n < 2; ++n) {
            const int gc = wc * 32 + fq * 8 + n * 4;
            const int fc = pn * 128 + gc;
            const f32x4 w0 = *(const f32x4*)(cw + fc), w1 = *(const f32x4*)(cw + DFF + fc), w2 = *(const f32x4*)(cw + 2 * DFF + fc), bb = *(const f32x4*)(cb + fc);
#pragma unroll
            for (int ai = 0; ai < 2; ++ai)
#pragma unroll
                for (int m = 0; m < 4; ++m) {
                    const int r = ai * 128 + wr * 64 + m * 16 + fr;
                    const f32x4 gv = acc[ai][0][m][n], uv = acc[ai][1][m][n];
                    if (r == 0 || r == 255) {
                        *(f32x4*)(ge + ((size_t)pm * 4 + (r == 0 ? 0 : 3)) * DFF + fc) = gv;
                        *(f32x4*)(ue + ((size_t)pm * 2 + (r == 0 ? 0 : 1)) * DFF + fc) = uv;
                    } else {
                        if (r == 1) *(f32x4*)(ge + ((size_t)pm * 4 + 1) * DFF + fc) = gv;
                        if (r == 254) *(f32x4*)(ge + ((size_t)pm * 4 + 2) * DFF + fc) = gv;
                        const f32x4 gm = *(const f32x4*)(G + (r - 1) * 132 + gc), gp = *(const f32x4*)(G + (r + 1) * 132 + gc);
                        f32x4 hv;
#pragma unroll
                        for (int j = 0; j < 4; ++j) { const float cv = w0[j] * gm[j] + w1[j] * gv[j] + w2[j] * gp[j] + bb[j]; hv[j] = siluf(cv) * uv[j]; }
                        u32x2 o; o[0] = pk2(hv[0], hv[1]); o[1] = pk2(hv[2], hv[3]);
                        *(u32x2*)(H + (size_t)(pm * 256 + r) * DFF + fc) = o;
                    }
                }
        }
        __syncthreads();
    }
};

template <int CTRL> __device__ __forceinline__ float dppf(float v) { return __int_as_float(__builtin_amdgcn_update_dpp(0, __float_as_int(v), CTRL, 0xF, 0xF, false)); }

struct EpiFfnP {
    bf16_t* H; float* ge; float* ue; const float* cw; const float* cb;
    __device__ __forceinline__ void operator()(const AccT& acc, int pm, int pn, int wr, int wc, int fr, int fq) const {
        extern __shared__ __attribute__((aligned(16))) unsigned char smem[];
        float* halo = (float*)(smem + 131072);
#pragma unroll
        for (int ai = 0; ai < 2; ++ai)
#pragma unroll
            for (int n = 0; n < 2; ++n) {
                if (fr == 0) *(f32x4*)(halo + ((ai * 2 + wr) * 2 + 0) * 128 + wc * 32 + fq * 8 + n * 4) = acc[ai][0][0][n];
                if (fr == 15) *(f32x4*)(halo + ((ai * 2 + wr) * 2 + 1) * 128 + wc * 32 + fq * 8 + n * 4) = acc[ai][0][3][n];
            }
        asm volatile("s_waitcnt lgkmcnt(0)" ::: "memory");
        __builtin_amdgcn_s_barrier();
        __builtin_amdgcn_s_barrier();
        asm volatile("" ::: "memory");
        u32x2 hold[2][4];
#pragma unroll
        for (int n = 0; n < 2; ++n) {
            const int gc = wc * 32 + fq * 8 + n * 4;
            const int fc = pn * 128 + gc;
            const f32x4 w0 = *(const f32x4*)(cw + fc), w1 = *(const f32x4*)(cw + DFF + fc), w2 = *(const f32x4*)(cw + 2 * DFF + fc), bb = *(const f32x4*)(cb + fc);
#pragma unroll
            for (int ai = 0; ai < 2; ++ai) {
                f32x4 ha = {0.f, 0.f, 0.f, 0.f}, hb = {0.f, 0.f, 0.f, 0.f};
                if (wr == 1) ha = *(const f32x4*)(halo + ((ai * 2 + 0) * 2 + 1) * 128 + gc);
                else if (ai == 1) ha = *(const f32x4*)(halo + ((0 * 2 + 1) * 2 + 1) * 128 + gc);
                if (wr == 0) hb = *(const f32x4*)(halo + ((ai * 2 + 1) * 2 + 0) * 128 + gc);
                else if (ai == 0) hb = *(const f32x4*)(halo + ((1 * 2 + 0) * 2 + 0) * 128 + gc);
#pragma unroll
                for (int m = 0; m < 4; ++m) {
                    const int r = ai * 128 + wr * 64 + m * 16 + fr;
                    const f32x4 gv = acc[ai][0][m][n], uv = acc[ai][1][m][n];
                    f32x4 gm, gp;
#pragma unroll
                    for (int j = 0; j < 4; ++j) {
                        if (m > 0) { const float t = (fr == 15) ? acc[ai][0][m > 0 ? m - 1 : 0][n][j] : gv[j]; gm[j] = dppf<0x121>(t); }
                        else { gm[j] = dppf<0x121>(gv[j]); if (fr == 0) gm[j] = ha[j]; }
                        if (m < 3) { const float t = (fr == 0) ? acc[ai][0][m < 3 ? m + 1 : 3][n][j] : gv[j]; gp[j] = dppf<0x12F>(t); }
                        else { gp[j] = dppf<0x12F>(gv[j]); if (fr == 15) gp[j] = hb[j]; }
                    }
                    if (r == 0 || r == 255) {
                        *(f32x4*)(ge + ((size_t)pm * 4 + (r == 0 ? 0 : 3)) * DFF + fc) = gv;
                        *(f32x4*)(ue + ((size_t)pm * 2 + (r == 0 ? 0 : 1)) * DFF + fc) = uv;
                    } else {
                        if (r == 1) *(f32x4*)(ge + ((size_t)pm * 4 + 1) * DFF + fc) = gv;
                        if (r == 254) *(f32x4*)(ge + ((size_t)pm * 4 + 2) * DFF + fc) = gv;
                        f32x4 hv;
#pragma unroll
                        for (int j = 0; j < 4; ++j) { const float cv = w0[j] * gm[j] + w1[j] * gv[j] + w2[j] * gp[j] + bb[j]; hv[j] = siluf(cv) * uv[j]; }
                        u32x2 o; o[0] = pk2(hv[0], hv[1]); o[1] = pk2(hv[2], hv[3]);
                        if (n == 0) hold[ai][m] = o;
                        else *(u32x4*)(H + (((size_t)pm * (DFF / 64) + (fc >> 6)) * 256 + r) * 64 + ((fc - 4) & 63)) = (u32x4){hold[ai][m][0], hold[ai][m][1], o[0], o[1]};
                    }
                }
            }
        }
    }
};

__device__ void ffn_edges(const Params& p) {
    bf16_t* H = (bf16_t*)(p.ws + OFF_PROJ);
    const float* ge = (const float*)(p.ws + OFF_GE);
    const float* ue = (const float*)(p.ws + OFF_UE);
    const int total = 320 * 2 * DFF;
    for (int idx = blockIdx.x * NTHR + threadIdx.x; idx < total; idx += gridDim.x * NTHR) {
        const int c = idx % DFF, e = (idx / DFF) & 1, pm = idx / (2 * DFF);
        const int tok = pm * 256 + (e ? 255 : 0);
        int s0, S; tok_seq(tok, s0, S);
        float gm, g0, gp, up;
        if (e == 0) {
            gm = (tok == s0) ? 0.f : ge[((size_t)(pm - 1) * 4 + 3) * DFF + c];
            g0 = ge[((size_t)pm * 4 + 0) * DFF + c]; gp = ge[((size_t)pm * 4 + 1) * DFF + c]; up = ue[((size_t)pm * 2 + 0) * DFF + c];
        } else {
            gm = ge[((size_t)pm * 4 + 2) * DFF + c]; g0 = ge[((size_t)pm * 4 + 3) * DFF + c];
            gp = (tok == s0 + S - 1) ? 0.f : ge[((size_t)(pm + 1) * 4 + 0) * DFF + c]; up = ue[((size_t)pm * 2 + 1) * DFF + c];
        }
        const float cv = p.ffn_conv_w[c] * gm + p.ffn_conv_w[DFF + c] * g0 + p.ffn_conv_w[2 * DFF + c] * gp + p.ffn_conv_b[c];
        H[(((size_t)(tok >> 8) * (DFF / 64) + (c >> 6)) * 256 + (tok & 255)) * 64 + (c & 63)] = f2bf(siluf(cv) * up);
    }
}

__device__ __forceinline__ void qk_norm_rope(const Params& p, int chunk, int h, int t6, int nthr) {
    bf16_t* proj = (bf16_t*)(p.ws + OFF_PROJ);
    bf16_t* kp = (bf16_t*)(p.ws + OFF_HN) + (size_t)T * 512;
    const int tk0 = chunk * 64;
    int s0, S; tok_seq(tk0, s0, S);
    const double INVF[8] = {0.15915494309189535, 0.03086376340470123, 0.005985185712713705, 0.001160663641240061,
                            0.00022507907903927653, 4.364795279280289e-05, 8.464330808241401e-06, 1.6414262627950345e-06};
    constexpr int NIT = 6;
    u32x4 rawv[NIT];
    const float gsub0 = 0.f; (void)gsub0;
#pragma unroll
    for (int it = 0; it < NIT; ++it) {
        const int item = t6 + it * nthr;
        if (item < 2048) {
            const int v = item >> 3, sub = item & 7, tokl = v >> 2, which = (v >> 1) & 1, c = v & 1;
            rawv[it] = *(const u32x4*)(proj + (size_t)(tk0 + tokl) * NPROJ + 2048 + which * 512 + h * 128 + c * 64 + sub * 8);
        }
    }
#pragma unroll
    for (int it = 0; it < NIT; ++it) {
        const int item = t6 + it * nthr;
        if (item < 2048) {
            const int v = item >> 3, sub = item & 7;
            const int tokl = v >> 2, which = (v >> 1) & 1, c = v & 1;
            const int tok = tk0 + tokl;
            bf16_t* ptr = proj + (size_t)tok * NPROJ + 2048 + which * 512 + h * 128 + c * 64 + sub * 8;
            const u32x4 raw = rawv[it];
            float f[8];
#pragma unroll
            for (int e = 0; e < 4; ++e) { f[2 * e] = bflo(raw[e]); f[2 * e + 1] = bfhi(raw[e]); }
            float ss = 0.f;
#pragma unroll
            for (int e = 0; e < 8; ++e) ss += f[e] * f[e];
            ss += __shfl_xor(ss, 1); ss += __shfl_xor(ss, 2); ss += __shfl_xor(ss, 4);
            const float rs = rsqrtf(ss * (1.f / 64.f) + EPS);
            float y[8], pr[8];
#pragma unroll
            for (int e = 0; e < 8; ++e) y[e] = f[e] * rs * p.da_qk_norm_g[which * 64 + sub * 8 + e];
#pragma unroll
            for (int e = 0; e < 8; ++e) pr[e] = __shfl_xor(y[e], 1);
            if (sub < 2) {
                const int pos = tok - s0;
#pragma unroll
                for (int e = 0; e < 8; ++e) {
                    const double rr = (double)pos * INVF[e];
                    const float fr_ = (float)(rr - floor(rr));
                    const float sn = __builtin_amdgcn_sinf(fr_), cs = __builtin_amdgcn_cosf(fr_);
                    y[e] = (sub == 0) ? (y[e] * cs - pr[e] * sn) : (y[e] * cs + pr[e] * sn);
                }
            }
            if (which == 0) {
#pragma unroll
                for (int e = 0; e < 8; ++e) y[e] *= 0.18033688011112042f;
            }
            const u32x4 yo = {pk2(y[0], y[1]), pk2(y[2], y[3]), pk2(y[4], y[5]), pk2(y[6], y[7])};
            if (which == 0) *(u32x4*)ptr = yo;
            else *(u32x4*)(kp + ((size_t)chunk * 4 + h) * 8192 + c * 4096 + tokl * 64 + sub * 8) = yo;
        }
    }
}

__device__ void dn_prep_unit(const Params& p, int chunk, int h) {
    extern __shared__ __attribute__((aligned(16))) unsigned char smem[];
    bf16_t* Kb = (bf16_t*)smem;
    float* Kf = (float*)(smem + 17408);
    float* Vf = (float*)(smem + 50176);
    float* KK = (float*)(smem + 82944);
    float* Am = (float*)(smem + 99584);
    float* gs = (float*)(smem + 132352);
    float* bs = gs + 128;
    float* gcs = bs + 128;
    float* es = gcs + 128;
    int tid_ = threadIdx.x; asm volatile("" : "+v"(tid_));
    const int tid = tid_, lane = tid & 63, wave = tid >> 6, fr = lane & 15, fq = lane >> 4;
    const bf16_t* proj = (const bf16_t*)(p.ws + OFF_PROJ);
    bf16_t* qn = (bf16_t*)(p.ws + OFF_QN);
    bf16_t* kn = (bf16_t*)(p.ws + OFF_KN);
    bf16_t* knt = (bf16_t*)(p.ws + OFF_KNT);
    const float* dab = (const float*)(p.ws + OFF_DAB);
    float* gcg = (float*)(p.ws + OFF_GC);
    bf16_t* ut = (bf16_t*)p.out;
    bf16_t* wrr = (bf16_t*)p.out + (size_t)10240 * 8192;
    const int tk0 = chunk * 64;
    int s0, S; tok_seq(tk0, s0, S);
    bf16_t* VsA = (bf16_t*)(smem + 99584);
#pragma unroll
    for (int it = 0; it < 2; ++it) {
        const int pi = tid + NTHR * it, row = pi >> 4, sub = pi & 15;
        const u32x4 raw = *(const u32x4*)(proj + (size_t)(tk0 + row) * NPROJ + 3072 + h * 128 + sub * 8);
        unsigned* dd = (unsigned*)(VsA + row * 130 + sub * 8);
        dd[0] = raw[0]; dd[1] = raw[1]; dd[2] = raw[2]; dd[3] = raw[3];
    }
    {
        const int rbase = tk0 + wave * 8;
#pragma unroll
        for (int mat = 0; mat < 3; ++mat) {
            const int colb = mat * 512 + h * 128 + 2 * lane;
            unsigned raw[12];
#pragma unroll
            for (int i = 0; i < 12; ++i) { const int t = rbase - 2 + i; raw[i] = (t >= s0 && t < s0 + S) ? *(const unsigned*)(proj + (size_t)t * NPROJ + colb) : 0u; }
            float cw0[5], cw1[5];
#pragma unroll
            for (int j = 0; j < 5; ++j) { cw0[j] = p.dn_conv_w[j * 1536 + colb]; cw1[j] = p.dn_conv_w[j * 1536 + colb + 1]; }
#pragma unroll
            for (int rr = 0; rr < 8; ++rr) {
                float o0 = 0.f, o1 = 0.f;
#pragma unroll
                for (int j = 0; j < 5; ++j) { o0 += cw0[j] * bflo(raw[rr + j]); o1 += cw1[j] * bfhi(raw[rr + j]); }
                o0 = siluf(o0); o1 = siluf(o1);
                const int row = wave * 8 + rr;
                if (mat < 2) {
                    float ss = wave_sum(o0 * o0 + o1 * o1);
                    float sc = rsqrtf(ss + EPS);
                    if (mat == 0) sc *= 0.08838834764831845f;
                    o0 *= sc; o1 *= sc;
                    const unsigned pk = pk2(o0, o1);
                    if (mat == 0) *(unsigned*)(qn + (size_t)(tk0 + row) * 512 + h * 128 + 2 * lane) = pk;
                    else {
                        *(unsigned*)(kn + (size_t)(tk0 + row) * 512 + h * 128 + 2 * lane) = pk;
                        *(unsigned*)(Kb + row * 136 + 2 * lane) = pk;
                        Kf[row * 128 + 2 * lane] = o0; Kf[row * 128 + 2 * lane + 1] = o1;
                    }
                } else { Vf[row * 128 + 2 * lane] = o0; Vf[row * 128 + 2 * lane + 1] = o1; }
            }
        }
        if (lane < 16) {
            const int rr = lane & 7, d = lane >> 3, row = wave * 8 + rr, t = tk0 + row;
            const float da = dab[(size_t)t * 16 + d * 4 + h], db = dab[(size_t)t * 16 + 8 + d * 4 + h];
            const float xx = da + p.dn_dt_bias[d * 4 + h];
            const float sp = fmaxf(xx, 0.f) + log1pf(__expf(-fabsf(xx)));
            gs[d * 64 + row] = -__expf(p.dn_a_log[d * 4 + h]) * sp;
            bs[d * 64 + row] = sigmoidf_(db);
        }
    }
    __syncthreads();
    if (wave < 2) {
        const int d = wave;
        float v = gs[d * 64 + lane];
#pragma unroll
        for (int off = 1; off < 64; off <<= 1) {
            const float tu = __shfl_up(v, off), td = __shfl_down(v, off);
            if (d == 0) { if (lane >= off) v += tu; } else { if (lane + off < 64) v += td; }
        }
        gcs[d * 64 + lane] = v;
        gcg[(size_t)(d * 4 + h) * T + tk0 + lane] = v;
    }
    {
        const int rt = wave & 3, ct0 = (wave >> 2) * 2;
#pragma unroll
        for (int cc = 0; cc < 2; ++cc) {
            const int ct = ct0 + cc;
            f32x4 a4 = {0.f, 0.f, 0.f, 0.f};
#pragma unroll
            for (int ks = 0; ks < 4; ++ks) {
                const bf16x8 a = *(const bf16x8*)(Kb + (rt * 16 + fr) * 136 + ks * 32 + fq * 8);
                const bf16x8 b = *(const bf16x8*)(Kb + (ct * 16 + fr) * 136 + ks * 32 + fq * 8);
                a4 = MFMA16(a, b, a4);
            }
#pragma unroll
            for (int j = 0; j < 4; ++j) KK[(rt * 16 + fq * 4 + j) * 65 + ct * 16 + fr] = a4[j];
        }
    }
    {
        bf16_t* vp = (bf16_t*)(p.ws + OFF_HN);
#pragma unroll
        for (int it = 0; it < 2; ++it) {
            const int item = tid + NTHR * it, dv = item >> 3, piece = item & 7;
            unsigned o[4];
#pragma unroll
            for (int e = 0; e < 4; ++e) { const unsigned lo = VsA[(piece * 8 + 2 * e) * 130 + dv], hi = VsA[(piece * 8 + 2 * e + 1) * 130 + dv]; o[e] = lo | (hi << 16); }
            *(u32x4*)(vp + ((size_t)chunk * 4 + h) * 8192 + dv * 64 + piece * 8) = (u32x4){o[0], o[1], o[2], o[3]};
        }
    }
    {
        const int dk = tid >> 2, piece = tid & 3;
        unsigned o[8];
#pragma unroll
        for (int e = 0; e < 8; ++e) o[e] = pk2(Kf[(piece * 16 + 2 * e) * 128 + dk], Kf[(piece * 16 + 2 * e + 1) * 128 + dk]);
        bf16_t* dst = knt + ((size_t)chunk * 4 + h) * 8192 + dk * 64 + piece * 16;
        *(u32x4*)dst = (u32x4){o[0], o[1], o[2], o[3]};
        *(u32x4*)(dst + 8) = (u32x4){o[4], o[5], o[6], o[7]};
    }
    __syncthreads();
    if (tid < 128) es[tid] = bs[tid] * __expf(gcs[tid]);
    for (int idx = tid; idx < 8192; idx += NTHR) {
        const int d = idx >> 12, ip = (idx >> 6) & 63, jp = idx & 63;
        const int ri = d ? 63 - ip : ip, rj = d ? 63 - jp : jp;
        float val = 0.f;
        if (jp < ip) val = bs[d * 64 + ri] * KK[ri * 65 + rj] * __expf(gcs[d * 64 + ri] - gcs[d * 64 + rj]);
        Am[idx] = val;
    }
    __syncthreads();
#ifndef NO_S5
    bf16_t* Tb0 = (bf16_t*)smem;
    bf16_t* Tb1 = (bf16_t*)(smem + 82944);
    if (__builtin_amdgcn_readfirstlane(wave) < 2) {
        const int d = __builtin_amdgcn_readfirstlane(wave), cp = lane;
        float x[64];
#pragma unroll
        for (int ip = 0; ip < 64; ++ip) x[ip] = (ip == cp) ? 1.f : 0.f;
        const float* Ad = Am + d * 4096;
        asm volatile("" : "+v"(Ad));
        f32x4 cur[4], nxt[4], dg[3];
#pragma unroll
        for (int k = 0; k < 3; ++k) dg[k] = *(const f32x4*)(Ad + (k + 1) * 64);
#pragma unroll
        for (int k = 0; k < 4; ++k) cur[k] = *(const f32x4*)(Ad + (4 + k) * 64);
#pragma unroll
        for (int b = 0; b < 16; ++b) {
            float t0 = 0.f, t1 = 0.f, t2 = 0.f, t3 = 0.f;
            f32x4 dn[3];
#pragma unroll
            for (int q = 0; q < b; ++q) {
                if (q + 1 < b) {
#pragma unroll
                    for (int k = 0; k < 4; ++k) nxt[k] = *(const f32x4*)(Ad + (4 * b + k) * 64 + (q + 1) * 4);
                } else {
#pragma unroll
                    for (int k = 0; k < 3; ++k) dg[k] = *(const f32x4*)(Ad + (4 * b + k + 1) * 64 + b * 4);
                    if (b < 15) {
#pragma unroll
                        for (int k = 0; k < 4; ++k) nxt[k] = *(const f32x4*)(Ad + (4 * (b + 1) + k) * 64);
                    }
                }
                t0 += cur[0][0] * x[4 * q] + cur[0][1] * x[4 * q + 1] + cur[0][2] * x[4 * q + 2] + cur[0][3] * x[4 * q + 3];
                t1 += cur[1][0] * x[4 * q] + cur[1][1] * x[4 * q + 1] + cur[1][2] * x[4 * q + 2] + cur[1][3] * x[4 * q + 3];
                t2 += cur[2][0] * x[4 * q] + cur[2][1] * x[4 * q + 1] + cur[2][2] * x[4 * q + 2] + cur[2][3] * x[4 * q + 3];
                t3 += cur[3][0] * x[4 * q] + cur[3][1] * x[4 * q + 1] + cur[3][2] * x[4 * q + 2] + cur[3][3] * x[4 * q + 3];
                asm volatile("" ::: "memory");
#pragma unroll
                for (int k = 0; k < 4; ++k) cur[k] = nxt[k];
            }
            (void)dn;
            x[4 * b] -= t0;
            x[4 * b + 1] -= t1 + dg[0][0] * x[4 * b];
            x[4 * b + 2] -= t2 + dg[1][0] * x[4 * b] + dg[1][1] * x[4 * b + 1];
            x[4 * b + 3] -= t3 + dg[2][0] * x[4 * b] + dg[2][1] * x[4 * b + 1] + dg[2][2] * x[4 * b + 2];
            asm volatile("" ::: "memory");
        }
        if (d == 0) {
#pragma unroll
            for (int ip = 0; ip < 64; ++ip) Tb0[ip * 72 + cp] = f2bf(x[ip]);
        } else {
#pragma unroll
            for (int ip = 0; ip < 64; ++ip) Tb1[(63 - ip) * 72 + (63 - cp)] = f2bf(x[ip]);
        }
    } else {
        qk_norm_rope(p, chunk, h, tid - 128, NTHR - 128);
    }
    __syncthreads();
    {
        const int d = __builtin_amdgcn_readfirstlane(wave >> 2), mat = __builtin_amdgcn_readfirstlane((wave >> 1) & 1), half = wave & 1;
        const bf16_t* Tb = d ? Tb1 : Tb0;
        const float* R = (mat ? Kf : Vf) + fq * 8 * 128 + half * 64 + fr;
        const float* sc = (mat ? es : bs) + d * 64 + fq * 8;
        asm volatile("" : "+v"(R), "+v"(sc));
        f32x4 acc[4][4];
#pragma unroll
        for (int c4 = 0; c4 < 4; ++c4)
#pragma unroll
            for (int rt = 0; rt < 4; ++rt) acc[c4][rt] = (f32x4){0.f, 0.f, 0.f, 0.f};
#pragma unroll
        for (int ks = 0; ks < 2; ++ks) {
            bf16x8 tf[4];
#pragma unroll
            for (int rt = 0; rt < 4; ++rt) tf[rt] = *(const bf16x8*)(Tb + (rt * 16 + fr) * 72 + ks * 32 + fq * 8);
            const f32x4 s0 = *(const f32x4*)(sc + ks * 32), s1 = *(const f32x4*)(sc + ks * 32 + 4);
#pragma unroll
            for (int c4 = 0; c4 < 4; ++c4) {
                const float* rp = R + ks * 32 * 128 + c4 * 16;
                u32x4 w;
                w[0] = pk2(rp[0] * s0[0], rp[128] * s0[1]); w[1] = pk2(rp[256] * s0[2], rp[384] * s0[3]);
                w[2] = pk2(rp[512] * s1[0], rp[640] * s1[1]); w[3] = pk2(rp[768] * s1[2], rp[896] * s1[3]);
                const bf16x8 rf = __builtin_bit_cast(bf16x8, w);
                if (mat == 0) {
#pragma unroll
                    for (int rt = 0; rt < 4; ++rt) acc[c4][rt] = MFMA16(tf[rt], rf, acc[c4][rt]);
                } else {
#pragma unroll
                    for (int rt = 0; rt < 4; ++rt) acc[c4][rt] = MFMA16(rf, tf[rt], acc[c4][rt]);
                }
                asm volatile("" ::: "memory");
            }
        }
        const size_t uid = ((size_t)d * NCHUNK + chunk) * 4 + h;
        if (mat == 0) {
#pragma unroll
            for (int c4 = 0; c4 < 4; ++c4)
#pragma unroll
                for (int rt = 0; rt < 4; ++rt) {
                    const f32x4 v = acc[c4][rt];
                    u32x2 o; o[0] = pk2(v[0], v[1]); o[1] = pk2(v[2], v[3]);
                    *(u32x2*)(ut + uid * 8192 + (size_t)((half * 4 + c4) * 16 + fr) * 64 + rt * 16 + fq * 4) = o;
                }
        } else {
#pragma unroll
            for (int c4 = 0; c4 < 4; ++c4)
#pragma unroll
                for (int rt = 0; rt < 4; ++rt) {
                    const f32x4 v = acc[c4][rt];
                    u32x2 o; o[0] = pk2(v[0], v[1]); o[1] = pk2(v[2], v[3]);
                    *(u32x2*)(wrr + uid * 8192 + (size_t)(rt * 16 + fr) * 128 + (half * 4 + c4) * 16 + fq * 4) = o;
                }
        }
    }
#endif
    __syncthreads();
}

__device__ void attn_prep_unit(const Params& p, int chunk, int h) {
    extern __shared__ __attribute__((aligned(16))) unsigned char smem[];
    bf16_t* Vs = (bf16_t*)smem;
    const int tid = threadIdx.x;
    bf16_t* proj = (bf16_t*)(p.ws + OFF_PROJ);
    bf16_t* vp = (bf16_t*)(p.ws + OFF_HN);
    bf16_t* kp = (bf16_t*)(p.ws + OFF_HN) + (size_t)T * 512;
    const int tk0 = chunk * 64;
    int s0, S; tok_seq(tk0, s0, S);
    const double INVF[8] = {0.15915494309189535, 0.03086376340470123, 0.005985185712713705, 0.001160663641240061,
                            0.00022507907903927653, 4.364795279280289e-05, 8.464330808241401e-06, 1.6414262627950345e-06};
#pragma unroll
    for (int it = 0; it < 4; ++it) {
        const int item = tid + NTHR * it, v = item >> 3, sub = item & 7;
        const int tokl = v >> 2, which = (v >> 1) & 1, c = v & 1;
        const int tok = tk0 + tokl;
        bf16_t* ptr = proj + (size_t)tok * NPROJ + 2048 + which * 512 + h * 128 + c * 64 + sub * 8;
        const u32x4 raw = *(const u32x4*)ptr;
        float f[8];
#pragma unroll
        for (int e = 0; e < 4; ++e) { f[2 * e] = bflo(raw[e]); f[2 * e + 1] = bfhi(raw[e]); }
        float ss = 0.f;
#pragma unroll
        for (int e = 0; e < 8; ++e) ss += f[e] * f[e];
        ss += __shfl_xor(ss, 1); ss += __shfl_xor(ss, 2); ss += __shfl_xor(ss, 4);
        const float rs = rsqrtf(ss * (1.f / 64.f) + EPS);
        float y[8], pr[8];
#pragma unroll
        for (int e = 0; e < 8; ++e) y[e] = f[e] * rs * p.da_qk_norm_g[which * 64 + sub * 8 + e];
#pragma unroll
        for (int e = 0; e < 8; ++e) pr[e] = __shfl_xor(y[e], 1);
        if (sub < 2) {
            const int pos = tok - s0;
#pragma unroll
            for (int e = 0; e < 8; ++e) {
                const double rr = (double)pos * INVF[e];
                const float fr_ = (float)(rr - floor(rr));
                const float sn = __builtin_amdgcn_sinf(fr_), cs = __builtin_amdgcn_cosf(fr_);
                y[e] = (sub == 0) ? (y[e] * cs - pr[e] * sn) : (y[e] * cs + pr[e] * sn);
            }
        }
        if (which == 0) {
#pragma unroll
            for (int e = 0; e < 8; ++e) y[e] *= 0.18033688011112042f;
        }
        const u32x4 yo = {pk2(y[0], y[1]), pk2(y[2], y[3]), pk2(y[4], y[5]), pk2(y[6], y[7])};
        if (which == 0) *(u32x4*)ptr = yo;
        else *(u32x4*)(kp + ((size_t)chunk * 4 + h) * 8192 + c * 4096 + tokl * 64 + sub * 8) = yo;
    }
#pragma unroll
    for (int it = 0; it < 2; ++it) {
        const int pi = tid + NTHR * it, row = pi >> 4, sub = pi & 15;
        const u32x4 raw = *(const u32x4*)(proj + (size_t)(tk0 + row) * NPROJ + 3072 + h * 128 + sub * 8);
        unsigned* d = (unsigned*)(Vs + row * 130 + sub * 8);
        d[0] = raw[0]; d[1] = raw[1]; d[2] = raw[2]; d[3] = raw[3];
    }
    __syncthreads();
#pragma unroll
    for (int it = 0; it < 2; ++it) {
        const int item = tid + NTHR * it, dv = item >> 3, piece = item & 7;
        unsigned o[4];
#pragma unroll
        for (int e = 0; e < 4; ++e) { const unsigned lo = Vs[(piece * 8 + 2 * e) * 130 + dv], hi = Vs[(piece * 8 + 2 * e + 1) * 130 + dv]; o[e] = lo | (hi << 16); }
        *(u32x4*)(vp + ((size_t)chunk * 4 + h) * 8192 + dv * 64 + piece * 8) = (u32x4){o[0], o[1], o[2], o[3]};
    }
    __syncthreads();
}

__device__ void dn_scan_unit(const Params& p, int u) {
    extern __shared__ __attribute__((aligned(16))) unsigned char smem[];
    bf16_t* Kb = (bf16_t*)smem;
    bf16_t* Vt = (bf16_t*)smem;
    bf16_t* Qb = (bf16_t*)(smem + 18432);
    bf16_t* QDb = (bf16_t*)(smem + 35840);
    bf16_t* KDt = (bf16_t*)(smem + 53248);
    bf16_t* Wb = (bf16_t*)(smem + 71680);
    bf16_t* St = (bf16_t*)(smem + 89088);
    bf16_t* QKm = (bf16_t*)(smem + 123904);
    float* gcs = (float*)(smem + 133120);
    const int tid = threadIdx.x, lane = tid & 63, wave = tid >> 6, fr = lane & 15, fq = lane >> 4;
    int sq, h, d;
    if (u < 128) { sq = 8 + (u >> 3); h = (u >> 1) & 3; d = u & 1; } else { const int u2 = u - 128; sq = u2 >> 3; h = (u2 >> 1) & 3; d = u2 & 1; }
    const int S = sq < 8 ? 2048 : 4096;
    const int s0 = sq < 8 ? sq * 2048 : TP + (sq - 8) * 4096;
    const int N = S / 64;
    const bf16_t* qn = (const bf16_t*)(p.ws + OFF_QN);
    const bf16_t* kn = (const bf16_t*)(p.ws + OFF_KN);
    const bf16_t* knt = (const bf16_t*)(p.ws + OFF_KNT);
    const float* gcg = (const float*)(p.ws + OFF_GC) + (size_t)(d * 4 + h) * T;
    const bf16_t* ut = (const bf16_t*)p.out;
    const bf16_t* wrr = (const bf16_t*)p.out + (size_t)10240 * 8192;
    bf16_t* proj = (bf16_t*)(p.ws + OFF_PROJ);
    f32x4 sacc[8];
#pragma unroll
    for (int i = 0; i < 8; ++i) sacc[i] = (f32x4){0.f, 0.f, 0.f, 0.f};
    for (int i = tid; i < 128 * 136 / 2; i += NTHR) ((unsigned*)St)[i] = 0u;
    __syncthreads();
    const int rt = wave & 3, cg4 = wave >> 2;
    u32x4 pkq[2], pqq[2], pww[2], pkk[2]; f32x4 pg0[2], pg1[2]; float pgr[2], pgcl, pgcs = 0.f; u32x2 puv[4];
#define SCAN_LOAD(NP) do { const int cis_ = d ? N - 1 - (NP) : (NP); const int tk_ = s0 + cis_ * 64; const int cg_ = tk_ >> 6; \
        const size_t uid_ = ((size_t)d * NCHUNK + cg_) * 4 + h; \
        pgcl = gcg[tk_ + (d ? 0 : 63)]; \
        _Pragma("unroll") for (int it = 0; it < 2; ++it) { const int pi = tid + NTHR * it, row = pi >> 4, sub = pi & 15; \
            pkq[it] = *(const u32x4*)(kn + (size_t)(tk_ + row) * 512 + h * 128 + sub * 8); \
            pqq[it] = *(const u32x4*)(qn + (size_t)(tk_ + row) * 512 + h * 128 + sub * 8); \
            pww[it] = *(const u32x4*)(wrr + uid_ * 8192 + row * 128 + sub * 8); \
            pgr[it] = gcg[tk_ + row]; \
            const int dk = pi >> 3, piece = pi & 7; \
            pkk[it] = *(const u32x4*)(knt + ((size_t)cg_ * 4 + h) * 8192 + dk * 64 + piece * 8); \
            pg0[it] = *(const f32x4*)(gcg + tk_ + piece * 8); pg1[it] = *(const f32x4*)(gcg + tk_ + piece * 8 + 4); } \
        if (tid < 64) pgcs = gcg[tk_ + tid]; \
        _Pragma("unroll") for (int c4 = 0; c4 < 4; ++c4) { const int ct = (wave >> 2) * 4 + c4; puv[c4] = *(const u32x2*)(ut + uid_ * 8192 + (size_t)(ct * 16 + fr) * 64 + (wave & 3) * 16 + fq * 4); } \
    } while (0)
    SCAN_LOAD(0);
    for (int np = 0; np < N; ++np) {
        const int cis = d ? N - 1 - np : np;
        const int tk0 = s0 + cis * 64;
        const float gcl = pgcl;
#pragma unroll
        for (int it = 0; it < 2; ++it) {
            const int pi = tid + NTHR * it, row = pi >> 4, sub = pi & 15;
            const float eg = __expf(pgr[it]);
            *(u32x4*)(Kb + row * 136 + sub * 8) = pkq[it];
            *(u32x4*)(Qb + row * 136 + sub * 8) = pqq[it];
            *(u32x4*)(Wb + row * 136 + sub * 8) = pww[it];
            u32x4 qd;
#pragma unroll
            for (int e = 0; e < 4; ++e) qd[e] = pk2(bflo(pqq[it][e]) * eg, bfhi(pqq[it][e]) * eg);
            *(u32x4*)(QDb + row * 136 + sub * 8) = qd;
            const int dk = pi >> 3, piece = pi & 7;
            const u32x4 kk = pkk[it]; const f32x4 g0 = pg0[it], g1 = pg1[it];
            u32x4 o;
            o[0] = pk2(bflo(kk[0]) * __expf(gcl - g0[0]), bfhi(kk[0]) * __expf(gcl - g0[1]));
            o[1] = pk2(bflo(kk[1]) * __expf(gcl - g0[2]), bfhi(kk[1]) * __expf(gcl - g0[3]));
            o[2] = pk2(bflo(kk[2]) * __expf(gcl - g1[0]), bfhi(kk[2]) * __expf(gcl - g1[1]));
            o[3] = pk2(bflo(kk[3]) * __expf(gcl - g1[2]), bfhi(kk[3]) * __expf(gcl - g1[3]));
            *(u32x4*)(KDt + dk * 72 + piece * 8) = o;
        }
        if (tid < 64) gcs[tid] = pgcs;
        u32x2 uv[4];
#pragma unroll
        for (int c4 = 0; c4 < 4; ++c4) uv[c4] = puv[c4];
        __syncthreads();
        if (np + 1 < N) SCAN_LOAD(np + 1);
#pragma unroll
        for (int cc = 0; cc < 2; ++cc) {
            const int ct = cg4 * 2 + cc;
            f32x4 a4 = {0.f, 0.f, 0.f, 0.f};
#pragma unroll
            for (int ks = 0; ks < 4; ++ks) {
                const bf16x8 a = *(const bf16x8*)(Qb + (rt * 16 + fr) * 136 + ks * 32 + fq * 8);
                const bf16x8 b = *(const bf16x8*)(Kb + (ct * 16 + fr) * 136 + ks * 32 + fq * 8);
                a4 = MFMA16(a, b, a4);
            }
            const int jj = ct * 16 + fr;
            const float gj = gcs[jj];
#pragma unroll
            for (int j = 0; j < 4; ++j) {
                const int i = rt * 16 + fq * 4 + j;
                const bool keep = d ? (jj >= i) : (jj <= i);
                const float val = keep ? a4[j] * __expf(gcs[i] - gj) : 0.f;
                QKm[i * 72 + jj] = f2bf(val);
            }
        }
        f32x4 ws4[4], qs4[4];
#pragma unroll
        for (int c4 = 0; c4 < 4; ++c4) { ws4[c4] = (f32x4){0.f, 0.f, 0.f, 0.f}; qs4[c4] = (f32x4){0.f, 0.f, 0.f, 0.f}; }
#pragma unroll
        for (int ks = 0; ks < 4; ++ks) {
            const bf16x8 aw = *(const bf16x8*)(Wb + (rt * 16 + fr) * 136 + ks * 32 + fq * 8);
            const bf16x8 aq = *(const bf16x8*)(QDb + (rt * 16 + fr) * 136 + ks * 32 + fq * 8);
#pragma unroll
            for (int c4 = 0; c4 < 4; ++c4) {
                const int ct = cg4 * 4 + c4;
                const bf16x8 b = *(const bf16x8*)(St + (ct * 16 + fr) * 136 + ks * 32 + fq * 8);
                ws4[c4] = MFMA16(aw, b, ws4[c4]);
                qs4[c4] = MFMA16(b, aq, qs4[c4]);
            }
        }
        __syncthreads();
#pragma unroll
        for (int c4 = 0; c4 < 4; ++c4) {
            const int ct = cg4 * 4 + c4;
            const float v0 = bflo(uv[c4][0]) - ws4[c4][0], v1 = bfhi(uv[c4][0]) - ws4[c4][1], v2 = bflo(uv[c4][1]) - ws4[c4][2], v3 = bfhi(uv[c4][1]) - ws4[c4][3];
            u32x2 o; o[0] = pk2(v0, v1); o[1] = pk2(v2, v3);
            *(u32x2*)(Vt + (ct * 16 + fr) * 72 + rt * 16 + fq * 4) = o;
        }
        __syncthreads();
#pragma unroll
        for (int ks = 0; ks < 2; ++ks) {
            const bf16x8 a = *(const bf16x8*)(QKm + (rt * 16 + fr) * 72 + ks * 32 + fq * 8);
#pragma unroll
            for (int c4 = 0; c4 < 4; ++c4) {
                const int ct = cg4 * 4 + c4;
                const bf16x8 b = *(const bf16x8*)(Vt + (ct * 16 + fr) * 72 + ks * 32 + fq * 8);
                qs4[c4] = MFMA16(b, a, qs4[c4]);
            }
        }
#pragma unroll
        for (int c4 = 0; c4 < 4; ++c4) {
            const int ct = cg4 * 4 + c4;
            { u32x2 o; o[0] = pk2(qs4[c4][0], qs4[c4][1]); o[1] = pk2(qs4[c4][2], qs4[c4][3]);
              *(u32x2*)(proj + (size_t)(tk0 + rt * 16 + fr) * NPROJ + d * 512 + h * 128 + ct * 16 + fq * 4) = o; }
        }
        const float gl = __expf(gcl);
#pragma unroll
        for (int c8 = 0; c8 < 8; ++c8) sacc[c8] = sacc[c8] * gl;
#pragma unroll
        for (int ks = 0; ks < 2; ++ks) {
            const bf16x8 a = *(const bf16x8*)(KDt + (wave * 16 + fr) * 72 + ks * 32 + fq * 8);
#pragma unroll
            for (int c8 = 0; c8 < 8; ++c8) {
                const bf16x8 b = *(const bf16x8*)(Vt + (c8 * 16 + fr) * 72 + ks * 32 + fq * 8);
                sacc[c8] = MFMA16(a, b, sacc[c8]);
            }
        }
#pragma unroll
        for (int c8 = 0; c8 < 8; ++c8) {
            u32x2 o; o[0] = pk2(sacc[c8][0], sacc[c8][1]); o[1] = pk2(sacc[c8][2], sacc[c8][3]);
            *(u32x2*)(St + (c8 * 16 + fr) * 136 + wave * 16 + fq * 4) = o;
        }
        __syncthreads();
    }
}

template <int ORD>
__device__ __forceinline__ void attn_unit(const Params& p, int a, float lam, float negC) {
    extern __shared__ __attribute__((aligned(16))) unsigned char smem[];
    int tid_ = threadIdx.x; asm volatile("" : "+v"(tid_));
    const int tid = tid_, lane = tid & 63, wave = tid >> 6, fr = lane & 15, fq = lane >> 4;
    int sq, h, qb;
    if (a < 2048) { sq = 8 + (a >> 7); const int rem = a & 127; h = rem >> 5; qb = rem & 31; }
    else { const int a2 = a - 2048; sq = a2 >> 6; const int rem = a2 & 63; h = rem >> 4; qb = rem & 15; }
    const int S = sq < 8 ? 2048 : 4096;
    const int s0 = sq < 8 ? sq * 2048 : TP + (sq - 8) * 4096;
    const int q0 = s0 + qb * 128, nt = S / 64;
    const int c = wave >> 2, wq = wave & 3;
    bf16_t* proj = (bf16_t*)(p.ws + OFF_PROJ);
    const bf16_t* vp = (const bf16_t*)(p.ws + OFF_HN) + ((size_t)(s0 >> 6) * 4 + h) * 8192;
    const bf16_t* kp = (const bf16_t*)(p.ws + OFF_HN) + (size_t)T * 512 + ((size_t)(s0 >> 6) * 4 + h) * 8192;
    bf16x8 qf[2][2];
#pragma unroll
    for (int rt = 0; rt < 2; ++rt)
#pragma unroll
        for (int ks = 0; ks < 2; ++ks)
            qf[rt][ks] = *(const bf16x8*)(proj + (size_t)(q0 + wq * 32 + rt * 16 + fr) * NPROJ + 2048 + h * 128 + c * 64 + ks * 32 + fq * 8);
    f32x4 ot[8][2];
#pragma unroll
    for (int dt = 0; dt < 8; ++dt) { ot[dt][0] = (f32x4){0.f, 0.f, 0.f, 0.f}; ot[dt][1] = (f32x4){0.f, 0.f, 0.f, 0.f}; }
    float lrow[2] = {0.f, 0.f};
    u32x4 kreg[2], vreg[2];
    const int kkey_ = tid >> 3;
    const int kperm = (((kkey_ >> 5) * 2 + ((kkey_ >> 2) & 1)) * 16) + ((kkey_ >> 3) & 3) * 4 + (kkey_ & 3);
#define ATT_LOAD(t) do { const bf16_t* kb_ = kp + (size_t)(t) * (4 * 8192); const bf16_t* vb_ = vp + (size_t)(t) * (4 * 8192); \
        kreg[0] = *(const u32x4*)(kb_ + tid * 8); kreg[1] = *(const u32x4*)(kb_ + 4096 + tid * 8); \
        vreg[0] = *(const u32x4*)(vb_ + tid * 8); vreg[1] = *(const u32x4*)(vb_ + 4096 + tid * 8); } while (0)
#define ATT_STORE(buf) do { bf16_t* Ks_ = (bf16_t*)(smem + (buf) * 36864); bf16_t* Vs_ = Ks_ + 9216; _Pragma("unroll") for (int it = 0; it < 2; ++it) { \
        *(u32x4*)(Ks_ + (it * 64 + kperm) * 72 + (tid & 7) * 8) = kreg[it]; \
        *(u32x4*)(Vs_ + ((tid >> 3) + it * 64) * 72 + (tid & 7) * 8) = vreg[it]; } } while (0)
    if (__builtin_amdgcn_readfirstlane(threadIdx.x) >= 256) __builtin_amdgcn_s_setprio(1);
    f32x4 st[4][2];
    bf16x8 pbp[2][2];
    {
        const u32x4 z4 = {0u, 0u, 0u, 0u};
        pbp[0][0] = pbp[0][1] = pbp[1][0] = pbp[1][1] = __builtin_bit_cast(bf16x8, z4);
        ATT_LOAD(0);
        ATT_STORE(0);
        ATT_LOAD(1);
        ATT_STORE(1);
        __syncthreads();
        bf16_t* Vz = (bf16_t*)(smem + 36864) + 9216;
        for (int i = tid; i < 9216 / 8; i += NTHR) *(u32x4*)(Vz + i * 8) = z4;
        const bf16_t* Ks = (const bf16_t*)smem;
#pragma unroll
        for (int kt = 0; kt < 4; ++kt) {
            st[kt][0] = (f32x4){negC, negC, negC, negC}; st[kt][1] = (f32x4){negC, negC, negC, negC};
#pragma unroll
            for (int ks = 0; ks < 2; ++ks) {
                const bf16x8 ka = *(const bf16x8*)(Ks + (c * 64 + kt * 16 + fr) * 72 + ks * 32 + fq * 8);
                st[kt][0] = MFMA16(ka, qf[0][ks], st[kt][0]);
                st[kt][1] = MFMA16(ka, qf[1][ks], st[kt][1]);
            }
        }
        __syncthreads();
    }
    for (int t = 0; t < nt; ++t) {
        { const int tk = (t + 2 < nt) ? t + 2 : nt - 1;
          const bf16_t* kb_ = kp + (size_t)tk * (4 * 8192); const bf16_t* vb_ = vp + (size_t)t * (4 * 8192);
          kreg[0] = *(const u32x4*)(kb_ + tid * 8); kreg[1] = *(const u32x4*)(kb_ + 4096 + tid * 8);
          vreg[0] = *(const u32x4*)(vb_ + tid * 8); vreg[1] = *(const u32x4*)(vb_ + 4096 + tid * 8); }
        const bf16_t* Ks = (const bf16_t*)(smem + ((t + 1) & 1) * 36864);
        const bf16_t* Vs = Ks + 9216;
        u32x4 pbn[2][2];
#pragma unroll
        for (int kt = 0; kt < 4; ++kt) {
            bf16x8 ka[2], va[2][2];
#pragma unroll
            for (int ks = 0; ks < 2; ++ks) ka[ks] = *(const bf16x8*)(Ks + (c * 64 + kt * 16 + fr) * 72 + ks * 32 + fq * 8);
#pragma unroll
            for (int dd = 0; dd < 2; ++dd)
#pragma unroll
                for (int s = 0; s < 2; ++s) {
                    const int dt = kt * 2 + dd;
                    va[dd][s] = *(const bf16x8*)(Vs + (dt * 16 + fr) * 72 + s * 32 + fq * 8);
                }
            if (ORD == 1) {
#pragma unroll
                for (int dd = 0; dd < 2; ++dd) {
                    const int dt = kt * 2 + dd;
#pragma unroll
                    for (int s = 0; s < 2; ++s) {
                        ot[dt][0] = MFMA16(va[dd][s], pbp[0][s], ot[dt][0]);
                        ot[dt][1] = MFMA16(va[dd][s], pbp[1][s], ot[dt][1]);
                    }
                }
                __builtin_amdgcn_sched_barrier(0);
            }
#pragma unroll
            for (int rt = 0; rt < 2; ++rt) {
                float pv[4];
#pragma unroll
                for (int j = 0; j < 4; ++j) pv[j] = __builtin_amdgcn_exp2f(st[kt][rt][j]);
                lrow[rt] += (pv[0] + pv[1]) + (pv[2] + pv[3]);
                pbn[rt][kt >> 1][(kt & 1) * 2] = pk2(pv[0], pv[1]);
                pbn[rt][kt >> 1][(kt & 1) * 2 + 1] = pk2(pv[2], pv[3]);
            }
            st[kt][0] = (f32x4){negC, negC, negC, negC}; st[kt][1] = (f32x4){negC, negC, negC, negC};
#pragma unroll
            for (int ks = 0; ks < 2; ++ks) {
                st[kt][0] = MFMA16(ka[ks], qf[0][ks], st[kt][0]);
                st[kt][1] = MFMA16(ka[ks], qf[1][ks], st[kt][1]);
            }
            if (ORD == 0) {
#pragma unroll
                for (int dd = 0; dd < 2; ++dd) {
                    const int dt = kt * 2 + dd;
#pragma unroll
                    for (int s = 0; s < 2; ++s) {
                        ot[dt][0] = MFMA16(va[dd][s], pbp[0][s], ot[dt][0]);
                        ot[dt][1] = MFMA16(va[dd][s], pbp[1][s], ot[dt][1]);
                    }
                }
            }
            __builtin_amdgcn_sched_barrier(0);
        }
        pbp[0][0] = __builtin_bit_cast(bf16x8, pbn[0][0]); pbp[0][1] = __builtin_bit_cast(bf16x8, pbn[0][1]);
        pbp[1][0] = __builtin_bit_cast(bf16x8, pbn[1][0]); pbp[1][1] = __builtin_bit_cast(bf16x8, pbn[1][1]);
        ATT_STORE(t & 1);
        __syncthreads();
    }
    {
        const bf16_t* Vs = (const bf16_t*)(smem + ((nt - 1) & 1) * 36864) + 9216;
#pragma unroll
        for (int dt = 0; dt < 8; ++dt)
#pragma unroll
            for (int s = 0; s < 2; ++s) {
                const bf16x8 va = *(const bf16x8*)(Vs + (dt * 16 + fr) * 72 + s * 32 + fq * 8);
                ot[dt][0] = MFMA16(va, pbp[0][s], ot[dt][0]);
                ot[dt][1] = MFMA16(va, pbp[1][s], ot[dt][1]);
            }
        __syncthreads();
    }
#undef ATT_LOAD
#undef ATT_STORE
    __builtin_amdgcn_s_setprio(0);
    float inv[2];
#pragma unroll
    for (int rt = 0; rt < 2; ++rt) { float l = lrow[rt]; l += __shfl_xor(l, 16); l += __shfl_xor(l, 32); inv[rt] = 1.f / l; }
    float* Ox = (float*)smem;
    if (c == 1) {
#pragma unroll
        for (int rt = 0; rt < 2; ++rt)
#pragma unroll
            for (int dt = 0; dt < 8; ++dt) *(f32x4*)(Ox + (wq * 32 + rt * 16 + fr) * 132 + dt * 16 + fq * 4) = ot[dt][rt] * inv[rt];
    }
    __syncthreads();
    if (c == 0) {
#pragma unroll
        for (int rt = 0; rt < 2; ++rt) {
            float ss = 0.f;
#pragma unroll
            for (int dt = 0; dt < 8; ++dt) {
                const f32x4 o2 = *(const f32x4*)(Ox + (wq * 32 + rt * 16 + fr) * 132 + dt * 16 + fq * 4);
                ot[dt][rt] = ot[dt][rt] * inv[rt] - lam * o2;
                ss += ot[dt][rt][0] * ot[dt][rt][0] + ot[dt][rt][1] * ot[dt][rt][1] + ot[dt][rt][2] * ot[dt][rt][2] + ot[dt][rt][3] * ot[dt][rt][3];
            }
            ss += __shfl_xor(ss, 16); ss += __shfl_xor(ss, 32);
            const float rs = rsqrtf(ss * (1.f / 128.f) + EPS) * 0.8f;
            const int row = q0 + wq * 32 + rt * 16 + fr;
#pragma unroll
            for (int dt = 0; dt < 8; ++dt) {
                const f32x4 g = *(const f32x4*)(p.da_subln_g + dt * 16 + fq * 4);
                const f32x4 v = ot[dt][rt] * rs * g;
                u32x2 o; o[0] = pk2(v[0], v[1]); o[1] = pk2(v[2], v[3]);
                *(u32x2*)(proj + (size_t)row * NPROJ + 2048 + h * 128 + dt * 16 + fq * 4) = o;
            }
        }
    }
    __syncthreads();
}

__device__ void dn_combine(const Params& p) {
    bf16_t* proj = (bf16_t*)(p.ws + OFF_PROJ);
    const int tid = threadIdx.x, lane = tid & 63, wave = tid >> 6;
    float gn[8];
#pragma unroll
    for (int e = 0; e < 8; ++e) gn[e] = p.dn_norm_g[(lane * 8 + e) & 127];
    for (int t0 = (blockIdx.x * 8 + wave) * 4; t0 < T; t0 += gridDim.x * 8 * 4) {
        u32x4 a[4], b[4], z[4];
#pragma unroll
        for (int k = 0; k < 4; ++k) { const bf16_t* row = proj + (size_t)(t0 + k) * NPROJ; a[k] = *(const u32x4*)(row + lane * 8); b[k] = *(const u32x4*)(row + 512 + lane * 8); z[k] = *(const u32x4*)(row + 1536 + lane * 8); }
#pragma unroll
        for (int k = 0; k < 4; ++k) {
            float s[8], zz[8];
#pragma unroll
            for (int e = 0; e < 4; ++e) { s[2 * e] = bflo(a[k][e]) + bflo(b[k][e]); s[2 * e + 1] = bfhi(a[k][e]) + bfhi(b[k][e]); zz[2 * e] = bflo(z[k][e]); zz[2 * e + 1] = bfhi(z[k][e]); }
            float ss = 0.f;
#pragma unroll
            for (int e = 0; e < 8; ++e) ss += s[e] * s[e];
            ss += __shfl_xor(ss, 1); ss += __shfl_xor(ss, 2); ss += __shfl_xor(ss, 4); ss += __shfl_xor(ss, 8);
            const float rs = rsqrtf(ss * (1.f / 128.f) + EPS);
            float y[8];
#pragma unroll
            for (int e = 0; e < 8; ++e) y[e] = s[e] * rs * gn[e] * siluf(zz[e]);
            *(u32x4*)(proj + (size_t)(t0 + k) * NPROJ + 1536 + lane * 8) = (u32x4){pk2(y[0], y[1]), pk2(y[2], y[3]), pk2(y[4], y[5]), pk2(y[6], y[7])};
        }
    }
}

__device__ void pe_convert(const Params& p) {
    bf16_t* pe = (bf16_t*)(p.ws + OFF_PE);
    const size_t total = (size_t)T * PLE / 4, stride = (size_t)gridDim.x * NTHR;
    for (size_t i0 = (size_t)blockIdx.x * NTHR + threadIdx.x; i0 < total; i0 += 4 * stride) {
        f32x4 v[4];
#pragma unroll
        for (int k = 0; k < 4; ++k) { const size_t i = i0 + k * stride; if (i < total) v[k] = *(const f32x4*)(prow(p, (int)(i >> 6)) + (int)(i & 63) * 4); }
#pragma unroll
        for (int k = 0; k < 4; ++k) { const size_t i = i0 + k * stride; if (i < total) { u32x2 o; o[0] = pk2(v[k][0], v[k][1]); o[1] = pk2(v[k][2], v[k][3]); *(u32x2*)(pe + (i >> 6) * PLE + (i & 63) * 4) = o; } }
    }
}

#ifndef DUMP_MODE
#define DUMP_MODE 6
#endif
__device__ void dump_phase(const Params& p) {
    const bf16_t* proj = (const bf16_t*)(p.ws + OFF_PROJ);
    const bf16_t* hn = (const bf16_t*)(p.ws + OFF_HN);
    const bf16_t* qk = (const bf16_t*)(p.ws + OFF_QK);
    const float* dab = (const float*)(p.ws + OFF_DAB);
    const float* gc = (const float*)(p.ws + OFF_GC);
    const size_t total = (size_t)T * DM;
    for (size_t i = (size_t)blockIdx.x * NTHR + threadIdx.x; i < total; i += (size_t)gridDim.x * NTHR) {
        const size_t t = i >> 10; const int c = (int)(i & 1023);
        float v = 1.f;
        if (DUMP_MODE == 1) v += bf2f(hn[i]) + dab[t * 16 + (c & 15)];
        if (DUMP_MODE == 2 || DUMP_MODE == 3) { v += bf2f(proj[t * NPROJ + c]) + bf2f(proj[t * NPROJ + 1024 + c]) + bf2f(proj[t * NPROJ + 2048 + c]); if (c < 512) v += bf2f(proj[t * NPROJ + 3072 + c]); }
        if (DUMP_MODE == 3) {
            v += bf2f(qk[i]);
            if (c < 512) v += bf2f(qk[total + t * 512 + c]);
            if (c < 512) v += bf2f(hn[t * 512 + c]);
            if (c < 8) v += gc[(size_t)c * T + t];
            const unsigned w = ((const unsigned*)p.out)[i];
            v += bflo(w) + bfhi(w);
        }
        if (DUMP_MODE == 4) { v += 100.f * bf2f(proj[t * NPROJ + c]); }
        if (DUMP_MODE == 5) { v += 100.f * bf2f(qk[i]); if (c < 512) v += 100.f * bf2f(qk[total + t * 512 + c]) + bf2f(hn[t * 512 + c]); if (c < 8) v += gc[(size_t)c * T + t]; v += bf2f(proj[t * NPROJ + 2048 + c]); }
        if (DUMP_MODE == 6) { const unsigned w = ((const unsigned*)p.out)[i]; v += fminf(fmaxf(bflo(w) + bfhi(w), -8.f), 8.f); }
        p.out[i] = v;
    }
}

#define XB_TMO      128
#define XB_XCNT(j)  (256  + 64 * (j))
#define XB_XSUB(j)  (1280 + 64 * (j))
#define XB_XGEN(j)  (2304 + 64 * (j))
#define XB_TOP      3328
#define XB_TOPGEN   3392
#define XCD_BAR_WORDS 3456
#define XB_SPIN_CAP (1u << 18)

__device__ __forceinline__ unsigned xb_ld(unsigned* p)              { return __hip_atomic_load(p, __ATOMIC_RELAXED, __HIP_MEMORY_SCOPE_AGENT); }
__device__ __forceinline__ unsigned xb_add(unsigned* p, unsigned v) { return __hip_atomic_fetch_add(p, v, __ATOMIC_RELAXED, __HIP_MEMORY_SCOPE_AGENT); }
__device__ __forceinline__ unsigned xb_xcc_id() { return (unsigned)__builtin_amdgcn_s_getreg((3 << 11) | 20) & 0xFu; }
#define XB_SPIN(cond, bar) do { unsigned _sp = 0; while (cond) { __builtin_amdgcn_s_sleep(1); \
    if ((++_sp & 255u) == 0u) { if (xb_ld(&(bar)[XB_TMO])) break; if (_sp > XB_SPIN_CAP) { atomicAdd(&(bar)[XB_TMO], 1u); break; } } } } while (0)

struct XcdBarrier {
    unsigned* bar; unsigned x;
    volatile LAS unsigned* st;
};

__device__ __forceinline__ XcdBarrier xcd_barrier_post(unsigned* bar, volatile LAS unsigned* st) {
    XcdBarrier b; b.bar = bar; b.x = xb_xcc_id(); b.st = st;
    if (threadIdx.x == 0) (void)xb_add(&bar[XB_XCNT(b.x)], 1u);
    return b;
}
__device__ __forceinline__ void xcd_barrier_complete(unsigned* bar, unsigned x, unsigned& nloc, unsigned& nx) {
    const unsigned G = gridDim.x * gridDim.y * gridDim.z;
    unsigned sum, cnt, mine, sp = 0u;
    for (;;) {
        sum = 0u; cnt = 0u; mine = 0u;
#pragma unroll
        for (unsigned j = 0; j < 16; ++j) { const unsigned c = xb_ld(&bar[XB_XCNT(j)]); sum += c; cnt += (c > 0u) ? 1u : 0u; mine = (j == x) ? c : mine; }
        if (sum == G) break;
        __builtin_amdgcn_s_sleep(1);
        if ((++sp & 255u) == 0u) { if (xb_ld(&bar[XB_TMO])) break; if (sp > XB_SPIN_CAP) { atomicAdd(&bar[XB_TMO], 1u); break; } }
    }
    nloc = mine > 0u ? mine : 1u; nx = cnt > 0u ? cnt : 1u;
}

__device__ __forceinline__ void xcd_barrier(const XcdBarrier& b) {
    asm volatile("s_waitcnt vmcnt(0)" ::: "memory");
    __syncthreads();
    if (threadIdx.x == 0) {
        unsigned* bar = b.bar;
        __builtin_amdgcn_s_waitcnt(0);
        unsigned nloc = b.st[0], nx = b.st[1];
        if (nloc == 0u) { xcd_barrier_complete(bar, b.x, nloc, nx); b.st[0] = nloc; b.st[1] = nx; }
        const unsigned old = xb_add(&bar[XB_XSUB(b.x)], 1u);
        const unsigned gen = old / nloc;
        if (old + 1u == (gen + 1u) * nloc) {
            __builtin_amdgcn_fence(__ATOMIC_RELEASE, "agent");
            asm volatile("s_waitcnt vmcnt(0)" ::: "memory");
            const unsigned og = xb_add(&bar[XB_TOP], 1u);
            const unsigned tg = og / nx;
            if (og + 1u == (tg + 1u) * nx) xb_add(&bar[XB_TOPGEN], 1u);
            else XB_SPIN(xb_ld(&bar[XB_TOPGEN]) == tg, bar);
            __builtin_amdgcn_fence(__ATOMIC_ACQUIRE, "agent");
            xb_add(&bar[XB_XGEN(b.x)], 1u);
            asm volatile("s_waitcnt vmcnt(0)" ::: "memory");
        } else {
            XB_SPIN(xb_ld(&bar[XB_XGEN(b.x)]) == gen, bar);
            __builtin_amdgcn_fence(__ATOMIC_ACQUIRE, "agent");
            asm volatile("s_waitcnt vmcnt(0)" ::: "memory");
        }
    }
    __syncthreads();
}


__global__ void __launch_bounds__(NTHR, 2) fwd_kernel(Params p) {
    __builtin_assume(__builtin_amdgcn_workitem_id_y() == 0);
    __builtin_assume(__builtin_amdgcn_workitem_id_z() == 0);
    extern __shared__ __attribute__((aligned(16))) unsigned char smem[];
    cg::grid_group grid = cg::this_grid();
    const int lo = p.ph_lo, hi = p.ph_hi;
#ifndef ONLY
#define ONLY -1
#endif
#define IN(k) ((ONLY < 0 || ONLY == (k)) && lo <= (k) && (k) < hi)
#ifdef PROBE_A
#define STAMP(k) do { if (blockIdx.x == 0 && threadIdx.x == 0) ((unsigned long long*)(p.ws + OFF_CTL + 512))[k] = __builtin_amdgcn_s_memrealtime(); } while (0)
#else
#define STAMP(k) do {} while (0)
#endif
#define SYNC(k) do { if (IN(k) && IN((k) + 1)) { if ((k) == 0) grid.sync(); else xcd_barrier(xbar); } STAMP((k) + 1); } while (0)
    unsigned* ctl = (unsigned*)(p.ws + OFF_CTL);
    volatile LAS unsigned* xst = (volatile LAS unsigned*)((LAS unsigned char*)smem + LDS_BYTES - 32);
    if (threadIdx.x < 2) xst[threadIdx.x] = 0u;
    __syncthreads();
    const XcdBarrier xbar = xcd_barrier_post((unsigned*)(p.ws + OFF_BAR), xst);
    STAMP(0);
    if (IN(0)) { if (blockIdx.x == 0 && threadIdx.x < 8) ctl[16 * threadIdx.x] = 0u;
        p0_weights(p); p0_tokens(p); }
    SYNC(0);
    if (IN(1)) { EpiProj e{(bf16_t*)(p.ws + OFF_PROJ)}; gemm_phase_p<EpiProj>((const bf16_t*)(p.ws + OFF_HN), DM, (const bf16_t*)(p.ws + OFF_WIN), T, NPROJ, DM, e, 0); }
    SYNC(1);
    if (IN(2)) {
        for (int u = blockIdx.x; u < NCHUNK * 4; u += gridDim.x) dn_prep_unit(p, u >> 2, u & 3);
    }
    SYNC(2);
    if (IN(3)) {
        for (int u = blockIdx.x; u < 192; u += gridDim.x) dn_scan_unit(p, u);
        STAMP(13);
        float l01 = 0.f, l23 = 0.f;
        for (int i = 0; i < 64; ++i) { l01 += p.da_lambda[i] * p.da_lambda[64 + i]; l23 += p.da_lambda[128 + i] * p.da_lambda[192 + i]; }
        const float lam = __expf(l01) - __expf(l23) + 0.2f;
        float gqm = 0.f, gkm = 0.f;
        for (int i = 0; i < 64; ++i) { gqm = fmaxf(gqm, fabsf(p.da_qk_norm_g[i])); gkm = fmaxf(gkm, fabsf(p.da_qk_norm_g[64 + i])); }
        const float negC = -64.f * 0.18033688f * gqm * gkm;
        int* sh = (int*)(smem + LDS_BYTES - 16);
        int victim = blockIdx.x & 7, tried = 0;
        while (true) {
            __syncthreads();
            if (threadIdx.x == 0) {
                int a = -1;
                while (tried < 8) {
                    const int j = (int)atomicAdd(ctl + 16 * victim, 1u);
                    if (j < 320) {
                        if (j < 256) { const int pair = victim + 8 * (j >> 5); a = pair * 32 + (j & 31); }
                        else { const int jj = j - 256; const int pair = victim + 8 * (jj >> 4); a = 2048 + pair * 16 + (jj & 15); }
                        break;
                    }
                    victim = (victim + 1) & 7; ++tried;
                }
                *sh = a;
            }
            __syncthreads();
            const int a = *sh;
            if (a < 0) break;
#ifndef SKIP_ATTN
            attn_unit<0>(p, a, lam, negC);
#endif
        }
    }
    SYNC(3);
    if (IN(4)) dn_combine(p);
    SYNC(4);
    if (IN(5)) { EpiResX e{{p.xp, p.xs, p.out}}; gemm_phase_p<EpiResX>((const bf16_t*)(p.ws + OFF_PROJ) + 1536, NPROJ, (const bf16_t*)(p.ws + OFF_WOUT), T, DM, DM, e, 0); }
    SYNC(5);
    if (IN(6)) { rmsnorm_pass(p.out, p.ln2_g, (bf16_t*)(p.ws + OFF_HN)); pe_convert(p); }
    SYNC(6);
    if (IN(7)) {
        EpiFfnP e{(bf16_t*)(p.ws + OFF_PROJ), (float*)(p.ws + OFF_GE), (float*)(p.ws + OFF_UE), p.ffn_conv_w, p.ffn_conv_b};
        gemm_phase_p<EpiFfnP>((const bf16_t*)(p.ws + OFF_HN), DM, (const bf16_t*)(p.ws + OFF_WUP), T, NUP, DM, e, 0);
        EpiEraw e2{(bf16_t*)(p.ws + OFF_ERAW), (float*)(p.ws + OFF_SSQ)};
        {
            const int bx = blockIdx.x;
            const int l0 = bx < 128 ? bx * 3 : 384 + (bx - 128) * 7, cnt = bx < 128 ? 3 : 7;
            if (gridDim.x == 256) gemm_phase_p<EpiEraw>((const bf16_t*)(p.ws + OFF_PE), PLE, (const bf16_t*)(p.ws + OFF_WPLE), T, DM, PLE, e2, 0, l0, 1, cnt);
            else gemm_phase_p<EpiEraw>((const bf16_t*)(p.ws + OFF_PE), PLE, (const bf16_t*)(p.ws + OFF_WPLE), T, DM, PLE, e2, 128);
        }
    }
    SYNC(7);
    if (IN(8)) ffn_edges(p);
    SYNC(8);
    if (IN(9)) { EpiAcc e{p.out}; gemm_phase_p<EpiAcc, true>((const bf16_t*)(p.ws + OFF_PROJ), DFF, (const bf16_t*)(p.ws + OFF_WDN), T, DM, DFF, e, 0); }
    SYNC(9);
    if (IN(10)) rmsnorm_pass(p.out, p.ple_gate_norm_g, (bf16_t*)(p.ws + OFF_HN));
    SYNC(10);
    if (IN(11)) {
        EpiFinal e{p.out, (const bf16_t*)(p.ws + OFF_ERAW), (const float*)(p.ws + OFF_SSQ), p.ple_norm_g};
        gemm_phase_p<EpiFinal>((const bf16_t*)(p.ws + OFF_HN), DM, (const bf16_t*)(p.ws + OFF_WG), T, DM, DM, e, 0);
    }
#ifdef DUMP_ON
    if (IN(12)) dump_phase(p);
#endif
#ifdef PROBE_A
    STAMP(12);
    grid.sync();
    if (blockIdx.x == 0) {
        const unsigned long long* ts = (const unsigned long long*)(p.ws + OFF_CTL + 512);
        const float dtA = (float)(ts[PROBE_A1] - ts[PROBE_A]) * 1e-5f, dtB = (float)(ts[PROBE_B1] - ts[PROBE_B]) * 1e-5f;
        if (threadIdx.x == 0) p.out[0] += 4.f * dtA;
        for (int j = threadIdx.x; j < 6711; j += NTHR) p.out[(size_t)TP * DM + j] += 0.5f * dtB;
    }
#endif
#undef IN
#undef SYNC
}

constexpr int NPHASE = 12;

extern "C" void kernel_launch(void* const* d_in, const int* in_sizes, int n_in, void* d_out, int out_size, void* d_ws, size_t ws_size, hipStream_t stream) {
    static int grid = 0;
    if (grid == 0) {
        if (n_in != 23 || ws_size < OFF_BAR + 16384) { fprintf(stderr, "kernel_launch: unexpected n_in %d / ws %zu (need %zu)\n", n_in, ws_size, (size_t)WS_END); grid = -1; return; }
        int dev = 0, cus = 0, per_cu = 0;
        hipGetDevice(&dev);
        hipDeviceGetAttribute(&cus, hipDeviceAttributeMultiprocessorCount, dev);
        if (hipFuncSetAttribute((const void*)fwd_kernel, hipFuncAttributeMaxDynamicSharedMemorySize, LDS_BYTES) != hipSuccess) { fprintf(stderr, "kernel_launch: hipFuncSetAttribute failed\n"); grid = -1; return; }
        if (hipOccupancyMaxActiveBlocksPerMultiprocessor(&per_cu, (const void*)fwd_kernel, NTHR, LDS_BYTES) != hipSuccess || per_cu < 1) { fprintf(stderr, "kernel_launch: occupancy query says %d\n", per_cu); per_cu = 1; }
        (void)hipGetLastError();
        grid = cus * per_cu;
    }
    if (grid < 0) return;
    (void)hipMemsetAsync((char*)d_ws + OFF_BAR, 0, 16384, stream);
    Params p{};
    p.xp = (const float*)d_in[0]; p.xs = (const float*)d_in[1]; p.pp = (const float*)d_in[2]; p.ps = (const float*)d_in[3];
    p.ln1_g = (const float*)d_in[4]; p.w_in = (const float*)d_in[5]; p.dn_conv_w = (const float*)d_in[6]; p.dn_a_log = (const float*)d_in[7];
    p.dn_dt_bias = (const float*)d_in[8]; p.dn_norm_g = (const float*)d_in[9]; p.da_qk_norm_g = (const float*)d_in[10]; p.da_lambda = (const float*)d_in[11];
    p.da_subln_g = (const float*)d_in[12]; p.w_out = (const float*)d_in[13]; p.ln2_g = (const float*)d_in[14]; p.w_up = (const float*)d_in[15];
    p.ffn_conv_w = (const float*)d_in[16]; p.ffn_conv_b = (const float*)d_in[17]; p.w_down = (const float*)d_in[18]; p.ple_proj = (const float*)d_in[19];
    p.ple_norm_g = (const float*)d_in[20]; p.ple_gate_norm_g = (const float*)d_in[21]; p.w_ple_gate = (const float*)d_in[22];
    p.out = (float*)d_out; p.ws = (unsigned char*)d_ws;
#if COOP
    p.ph_lo = 0; p.ph_hi = NPHASE;
    void* args[] = {&p};
    hipError_t e = hipLaunchCooperativeKernel((const void*)fwd_kernel, dim3(grid), dim3(NTHR), args, LDS_BYTES, stream);
    if (e != hipSuccess) fprintf(stderr, "cooperative launch failed: %s (grid %d)\n", hipGetErrorString(e), grid);
#else
#ifndef PH_LIMIT
#define PH_LIMIT NPHASE
#endif
    for (int ph = 0; ph < PH_LIMIT; ++ph) {
        p.ph_lo = ph; p.ph_hi = ph + 1;
        hipLaunchKernelGGL(fwd_kernel, dim3(grid), dim3(NTHR), LDS_BYTES, stream, p);
    }
#ifdef DUMP_ON
    p.ph_lo = 12; p.ph_hi = 13;
    hipLaunchKernelGGL(fwd_kernel, dim3(grid), dim3(NTHR), LDS_BYTES, stream, p);
#endif
#endif
}
```
